# Optimizing an MI355X kernel written in HIP

```python
import math
import jax, jax.numpy as jnp
from jax import lax
import numpy as np

D_MODEL = 1024
BATCH = 32
SEQ = 2048
DEPTH = 2
DEC_BATCH = 16
DEC_SEQ = 16
PAST_LEN = 4096

CHUNK = 64
Q_BLOCK = 128
HEAD_DIM = 64
N_HEADS_A = 8
N_HEADS_B = 8
WIDTH_A = N_HEADS_A * HEAD_DIM
WIDTH_B = N_HEADS_B * HEAD_DIM
MIX_WIDTH = WIDTH_A + WIDTH_B
IN_DIM = 4 * WIDTH_A + N_HEADS_A + 4 * WIDTH_B
EPS = 1e-6
FORGET_BIAS_INIT = 3.0

kernel_name = "fox_stickbreak_hybrid_stream_step"


def rmsnorm(x, g):
    xf = x.astype(jnp.float32)
    y = xf * lax.rsqrt(jnp.mean(xf * xf, axis=-1, keepdims=True) + EPS)
    return (y * g.astype(jnp.float32)).astype(x.dtype)


def project(h, w_in, b_f):
    b, t, _ = h.shape
    u = jnp.einsum("btd,de->bte", h, w_in)
    sizes = (WIDTH_A, WIDTH_A, WIDTH_A, N_HEADS_A, WIDTH_A,
             WIDTH_B, WIDTH_B, WIDTH_B, WIDTH_B)
    idx, acc = [], 0
    for s in sizes[:-1]:
        acc += s
        idx.append(acc)
    qa, ka, va, fa, za, qb, kb, vb, zb = jnp.split(u, idx, axis=-1)
    hd = lambda a, n: a.reshape(b, t, n, HEAD_DIM)
    logf = jax.nn.log_sigmoid((fa + b_f).astype(jnp.float32))
    return (hd(qa, N_HEADS_A), hd(ka, N_HEADS_A), hd(va, N_HEADS_A), logf, za,
            hd(qb, N_HEADS_B), hd(kb, N_HEADS_B), hd(vb, N_HEADS_B), zb)


def fox_attend(q, k, v, cq, ck, q_pos, k_pos):
    s = jnp.einsum("bqhd,bkhd->bhqk", q, k, preferred_element_type=jnp.float32) * (HEAD_DIM ** -0.5)
    bias = jnp.swapaxes(cq, 1, 2)[:, :, :, None] - jnp.swapaxes(ck, 1, 2)[:, :, None, :]
    mask = k_pos[None, :] <= q_pos[:, None]
    p = jax.nn.softmax(jnp.where(mask, s + bias, -jnp.inf), axis=-1)
    return jnp.einsum("bhqk,bkhd->bqhd", p.astype(v.dtype), v)


def sb_attend(q, k, v, q_pos, k_pos):
    z = jnp.einsum("bqhd,bkhd->bhqk", q, k, preferred_element_type=jnp.float32) * (HEAD_DIM ** -0.5)
    mask = k_pos[None, :] < q_pos[:, None]
    log_1m = jnp.where(mask, jax.nn.log_sigmoid(-z), 0.0)
    suffix = lax.cumsum(log_1m, axis=3, reverse=True) - log_1m
    a = jnp.where(mask, jnp.exp(jax.nn.log_sigmoid(z) + suffix), 0.0)
    return jnp.einsum("bhqk,bkhd->bqhd", a.astype(v.dtype), v)


def merge(oa, za, ob, zb, gn_a, gn_b, w_out):
    b, t = oa.shape[0], oa.shape[1]
    ya = rmsnorm(oa.reshape(b, t, WIDTH_A), gn_a) * jax.nn.silu(za)
    yb = rmsnorm(ob.reshape(b, t, WIDTH_B), gn_b) * jax.nn.silu(zb)
    return jnp.einsum("bte,ed->btd", jnp.concatenate([ya, yb], axis=-1), w_out)


def prompt_attention(qa, ka, va, logf, qb, kb, vb):
    t = qa.shape[1]
    c = jnp.cumsum(logf, axis=1)
    pos = jnp.arange(t)
    outs_a, outs_b = [], []
    for i in range(t // Q_BLOCK):
        lo, hi = i * Q_BLOCK, (i + 1) * Q_BLOCK
        outs_a.append(fox_attend(qa[:, lo:hi], ka[:, :hi], va[:, :hi],
                                 c[:, lo:hi], c[:, :hi], pos[lo:hi], pos[:hi]))
        outs_b.append(sb_attend(qb[:, lo:hi], kb[:, :hi], vb[:, :hi], pos[lo:hi], pos[:hi]))
    return jnp.concatenate(outs_a, axis=1), jnp.concatenate(outs_b, axis=1)


def sample_attention(qa, ka, va, logf, qb, kb, vb, ck_a, cv_a, cf_a, ck_b, cv_b):
    p, t = ck_a.shape[1], qa.shape[1]
    ka_all = jnp.concatenate([ck_a.astype(ka.dtype), ka], axis=1)
    va_all = jnp.concatenate([cv_a.astype(va.dtype), va], axis=1)
    kb_all = jnp.concatenate([ck_b.astype(kb.dtype), kb], axis=1)
    vb_all = jnp.concatenate([cv_b.astype(vb.dtype), vb], axis=1)
    c_all = jnp.cumsum(jnp.concatenate([cf_a.astype(jnp.float32), logf], axis=1), axis=1)
    k_pos = jnp.arange(p + t)
    q_pos = p + jnp.arange(t)
    oa = fox_attend(qa, ka_all, va_all, c_all[:, p:], c_all, q_pos, k_pos)
    ob = sb_attend(qb, kb_all, vb_all, q_pos, k_pos)
    return oa, ob


def setup_inputs(seed: int = 0) -> dict:
    key = jax.random.key(seed)
    ks = jax.random.split(key, 16)
    nrm = lambda k, shape: jax.random.normal(k, shape, jnp.float32)
    cache_a = (DEPTH, DEC_BATCH, PAST_LEN, N_HEADS_A, HEAD_DIM)
    cache_b = (DEPTH, DEC_BATCH, PAST_LEN, N_HEADS_B, HEAD_DIM)
    return {
        "x_prompt": nrm(ks[0], (BATCH, SEQ, D_MODEL)),
        "x_sample": nrm(ks[1], (DEC_BATCH, DEC_SEQ, D_MODEL)),
        "cache_fox_k": nrm(ks[2], cache_a),
        "cache_fox_v": nrm(ks[3], cache_a),
        "cache_fox_logf": jax.nn.log_sigmoid(FORGET_BIAS_INIT + nrm(ks[4], (DEPTH, DEC_BATCH, PAST_LEN, N_HEADS_A))),
        "cache_sb_k": nrm(ks[5], cache_b),
        "cache_sb_v": nrm(ks[6], cache_b),
        "norm_g": 1.0 + 0.01 * nrm(ks[7], (DEPTH, D_MODEL)),
        "w_in": nrm(ks[8], (DEPTH, D_MODEL, IN_DIM)) * D_MODEL ** -0.5,
        "b_f": FORGET_BIAS_INIT + 0.1 * nrm(ks[9], (DEPTH, N_HEADS_A)),
        "out_norm_a": 1.0 + 0.01 * nrm(ks[10], (DEPTH, WIDTH_A)),
        "out_norm_b": 1.0 + 0.01 * nrm(ks[11], (DEPTH, WIDTH_B)),
        "w_out": nrm(ks[12], (DEPTH, MIX_WIDTH, D_MODEL)) * MIX_WIDTH ** -0.5,
        "final_norm_g": 1.0 + 0.01 * nrm(ks[13], (D_MODEL,)),
    }


def reference(x_prompt, x_sample, cache_fox_k, cache_fox_v, cache_fox_logf, cache_sb_k, cache_sb_v,
              norm_g, w_in, b_f, out_norm_a, out_norm_b, w_out, final_norm_g):
    xp, xs = x_prompt, x_sample
    p_ka, p_va, p_fa, p_kb, p_vb = [], [], [], [], []
    s_ka, s_va, s_fa, s_kb, s_vb = [], [], [], [], []
    for l in range(DEPTH):
        hp = rmsnorm(xp, norm_g[l])
        qa, ka, va, logf, za, qb, kb, vb, zb = project(hp, w_in[l], b_f[l])
        oa, ob = prompt_attention(qa, ka, va, logf, qb, kb, vb)
        xp = xp + merge(oa, za, ob, zb, out_norm_a[l], out_norm_b[l], w_out[l])
        p_ka.append(ka); p_va.append(va); p_fa.append(logf); p_kb.append(kb); p_vb.append(vb)

        hs = rmsnorm(xs, norm_g[l])
        qa, ka, va, logf, za, qb, kb, vb, zb = project(hs, w_in[l], b_f[l])
        oa, ob = sample_attention(qa, ka, va, logf, qb, kb, vb,
                                  cache_fox_k[l], cache_fox_v[l], cache_fox_logf[l],
                                  cache_sb_k[l], cache_sb_v[l])
        xs = xs + merge(oa, za, ob, zb, out_norm_a[l], out_norm_b[l], w_out[l])
        s_ka.append(ka); s_va.append(va); s_fa.append(logf); s_kb.append(kb); s_vb.append(vb)

    y_prompt = rmsnorm(xp, final_norm_g)
    y_sample = rmsnorm(xs, final_norm_g)
    return (y_prompt, y_sample,
            jnp.stack(p_ka), jnp.stack(p_va), jnp.stack(p_fa), jnp.stack(p_kb), jnp.stack(p_vb),
            jnp.stack(s_ka), jnp.stack(s_va), jnp.stack(s_fa), jnp.stack(s_kb), jnp.stack(s_vb))
```

```cpp
#include <hip/hip_runtime.h>
#include <cstdio>
#include <cstdint>

constexpr int D = 1024, NB = 32, T = 2048, MP = NB * T;
constexpr int DB = 16, DT = 16, MS = DB * DT, MT = MP + MS;
constexpr int PAST = 4096, SKV = PAST + DT;
constexpr int H = 8, HD = 64, W = 512, IN_DIM = 4104, NPROJ = 4096;
constexpr float EPS = 1e-6f;
constexpr float LOG2E = 1.4426950408889634f;
constexpr float C2 = 0.125f * LOG2E;

constexpr size_t O_YP = 0, O_YS = O_YP + (size_t)MP * D, O_FKP = O_YS + (size_t)MS * D, O_FVP = O_FKP + 2ull * MP * W, O_FLP = O_FVP + 2ull * MP * W,
                 O_SKP = O_FLP + 2ull * MP * H, O_SVP = O_SKP + 2ull * MP * W, O_FKS = O_SVP + 2ull * MP * W, O_FVS = O_FKS + 2ull * MS * W,
                 O_FLS = O_FVS + 2ull * MS * W, O_SKS = O_FLS + 2ull * MS * H, O_SVS = O_SKS + 2ull * MS * W, O_END = O_SVS + 2ull * MS * W;

constexpr size_t MiB = 1u << 20;
constexpr size_t WS_CTL = 0, CTL_ZERO_BYTES = 64 * 1024;
constexpr size_t WS_WIN = 1 * MiB;
constexpr size_t WS_WOUT = 17 * MiB;
constexpr size_t WS_WF = 21 * MiB;
constexpr size_t WS_CKP = 22 * MiB;
constexpr size_t WS_CKS = 24 * MiB;
constexpr size_t WS_SSQ = 27 * MiB;
constexpr size_t WS_HN = 32 * MiB;
constexpr size_t WS_Q = 161 * MiB, WS_K = 290 * MiB, WS_V = 419 * MiB, WS_Z = 548 * MiB;
constexpr size_t WS_XP = 677 * MiB;
constexpr size_t WS_RSTD = 21 * MiB + 512 * 1024;
constexpr size_t WS_END = 935 * MiB;
static_assert((size_t)MT * D * 2 <= 129 * MiB && (size_t)MT * D * 4 <= 258 * MiB, "ws map");
constexpr int CW_BAR = 4096;
constexpr int CW_QUEUE = 8192;

typedef unsigned short bf16;
typedef float f32x4 __attribute__((ext_vector_type(4)));
typedef unsigned u32x4 __attribute__((ext_vector_type(4)));
typedef unsigned u32x2 __attribute__((ext_vector_type(2)));
#define LAS __attribute__((address_space(3)))

__device__ __forceinline__ bf16 f2bf(float f) { unsigned u = __float_as_uint(f); u += 0x7fffu + ((u >> 16) & 1u); return (bf16)(u >> 16); }
__device__ __forceinline__ float bf2f(bf16 h) { return __uint_as_float((unsigned)h << 16); }
__device__ __forceinline__ unsigned pk2(float lo, float hi) { return (unsigned)f2bf(lo) | ((unsigned)f2bf(hi) << 16); }
__device__ __forceinline__ float bflo(unsigned w) { return __uint_as_float(w << 16); }
__device__ __forceinline__ float bfhi(unsigned w) { return __uint_as_float(w & 0xffff0000u); }
template <int CTRL> __device__ __forceinline__ float dpp_mov(float v) { return __int_as_float(__builtin_amdgcn_update_dpp(0, __float_as_int(v), CTRL, 0xF, 0xF, false)); }
__device__ __forceinline__ float sum8_dpp(float v) {
    v += dpp_mov<0xB1>(v);
    v += dpp_mov<0x4E>(v);
    v += dpp_mov<0x141>(v);
    return v;
}
__device__ __forceinline__ float wave_sum(float v) {
    v = sum8_dpp(v);
    v += dpp_mov<0x140>(v);
    return __int_as_float(__builtin_amdgcn_readlane(__float_as_int(v), 0)) + __int_as_float(__builtin_amdgcn_readlane(__float_as_int(v), 16))
         + __int_as_float(__builtin_amdgcn_readlane(__float_as_int(v), 32)) + __int_as_float(__builtin_amdgcn_readlane(__float_as_int(v), 48));
}
__device__ __forceinline__ float gate_reduce(const f32x4& f0, const f32x4& f1, int lane) {
    const bool h4 = lane & 16, h3 = lane & 8;
    f32x4 k4;
#pragma unroll
    for (int i = 0; i < 4; ++i) { auto rr = __builtin_amdgcn_permlane32_swap(__float_as_uint(f0[i]), __float_as_uint(f1[i]), false, false); k4[i] = __uint_as_float(rr[0]) + __uint_as_float(rr[1]); }
    float k2a, k2b; { const float m0 = h4 ? k4[2] : k4[0], m1 = h4 ? k4[3] : k4[1], g0 = h4 ? k4[0] : k4[2], g1 = h4 ? k4[1] : k4[3];
        k2a = m0 + __shfl_xor(g0, 16); k2b = m1 + __shfl_xor(g1, 16); }
    const float m0 = h3 ? k2b : k2a, g0 = h3 ? k2a : k2b;
    return sum8_dpp(m0 + dpp_mov<0x140>(g0));
}

#define XB_TMO      128
#define XB_XCNT(j)  (256  + 64 * (j))
#define XB_XSUB(j)  (1280 + 64 * (j))
#define XB_XGEN(j)  (2304 + 64 * (j))
#define XB_TOP      3328
#define XB_TOPGEN   3392
#define XCD_BAR_WORDS 3456
#define XB_SPIN_CAP (1u << 24)
__device__ __forceinline__ unsigned xb_ld(unsigned* p)              { return __hip_atomic_load(p, __ATOMIC_RELAXED, __HIP_MEMORY_SCOPE_AGENT); }
__device__ __forceinline__ unsigned xb_add(unsigned* p, unsigned v) { return __hip_atomic_fetch_add(p, v, __ATOMIC_RELAXED, __HIP_MEMORY_SCOPE_AGENT); }
__device__ __forceinline__ unsigned xb_xcc_id() { return (unsigned)__builtin_amdgcn_s_getreg((3 << 11) | 20) & 0xFu; }
#define XB_SPIN(cond, bar) do { unsigned _sp = 0; while (cond) { __builtin_amdgcn_s_sleep(1); \
    if ((++_sp & 255u) == 0u) { if (xb_ld(&(bar)[XB_TMO])) break; if (_sp > XB_SPIN_CAP) { atomicAdd(&(bar)[XB_TMO], 1u); break; } } } } while (0)
struct XcdBarrier { unsigned* bar; unsigned x; volatile LAS unsigned* st; };
__device__ __forceinline__ XcdBarrier xcd_barrier_post(unsigned* bar, volatile LAS unsigned* st) {
    XcdBarrier b; b.bar = bar; b.x = xb_xcc_id(); b.st = st;
    if (threadIdx.x == 0) (void)xb_add(&bar[XB_XCNT(b.x)], 1u);
    return b;
}
__device__ __forceinline__ void xcd_barrier_complete(unsigned* bar, unsigned x, unsigned& nloc, unsigned& nx) {
    const unsigned G = gridDim.x * gridDim.y * gridDim.z;
    unsigned sum, cnt, mine, sp = 0u;
    for (;;) {
        sum = 0u; cnt = 0u; mine = 0u;
#pragma unroll
        for (unsigned j = 0; j < 16; ++j) { const unsigned c = xb_ld(&bar[XB_XCNT(j)]); sum += c; cnt += (c > 0u) ? 1u : 0u; mine = (j == x) ? c : mine; }
        if (sum == G) break;
        __builtin_amdgcn_s_sleep(1);
        if ((++sp & 255u) == 0u) { if (xb_ld(&bar[XB_TMO])) break; if (sp > XB_SPIN_CAP) { atomicAdd(&bar[XB_TMO], 1u); break; } }
    }
    nloc = mine > 0u ? mine : 1u; nx = cnt > 0u ? cnt : 1u;
}
__device__ __forceinline__ void xcd_barrier(const XcdBarrier& b) {
    asm volatile("s_waitcnt vmcnt(0)" ::: "memory");
    __syncthreads();
    if (threadIdx.x == 0) {
        unsigned* bar = b.bar;
        __builtin_amdgcn_s_waitcnt(0);
        unsigned nloc = b.st[0], nx = b.st[1];
        if (nloc == 0u) { xcd_barrier_complete(bar, b.x, nloc, nx); b.st[0] = nloc; b.st[1] = nx; }
        const unsigned old = xb_add(&bar[XB_XSUB(b.x)], 1u);
        const unsigned gen = old / nloc;
        if (old + 1u == (gen + 1u) * nloc) {
            __builtin_amdgcn_fence(__ATOMIC_RELEASE, "agent");
            asm volatile("s_waitcnt vmcnt(0)" ::: "memory");
            const unsigned og = xb_add(&bar[XB_TOP], 1u);
            const unsigned tg = og / nx;
            if (og + 1u == (tg + 1u) * nx) xb_add(&bar[XB_TOPGEN], 1u);
            else XB_SPIN(xb_ld(&bar[XB_TOPGEN]) == tg, bar);
            __builtin_amdgcn_fence(__ATOMIC_ACQUIRE, "agent");
            xb_add(&bar[XB_XGEN(b.x)], 1u);
            asm volatile("s_waitcnt vmcnt(0)" ::: "memory");
        } else {
            XB_SPIN(xb_ld(&bar[XB_XGEN(b.x)]) == gen, bar);
            __builtin_amdgcn_fence(__ATOMIC_ACQUIRE, "agent");
            asm volatile("s_waitcnt vmcnt(0)" ::: "memory");
        }
    }
    __syncthreads();
}

namespace pg8 {
#define PG8_LAS __attribute__((address_space(3)))
typedef unsigned short bf16_t;
typedef short bf16x8 __attribute__((ext_vector_type(8)));
typedef float f32x4 __attribute__((ext_vector_type(4)));
typedef unsigned u32x4 __attribute__((ext_vector_type(4)));
constexpr int BM = 256, BK = 64, HALF = 128, HTB = HALF * BK * 2  , STAGE_BYTES = 8 * HTB, NXCD = 8, WGM = 8;

__host__ __device__ __forceinline__ int lds_byte(int r, int c) { const int st = (r >> 4) * 2 + (c >> 5), rr = r & 15, cc = c & 31, ob = rr * 64 + cc * 2; return st * 1024 + (ob ^ (((ob >> 9) & 1) << 5)); }
__host__ __device__ __forceinline__ void stage_rc(int b, int& R, int& C) { const int st = b / 1024, sb = b % 1024, swz = sb ^ (((sb >> 9) & 1) << 5); R = (st >> 1) * 16 + swz / 64; C = (st & 1) * 32 + (swz % 64) / 2; }
__host__ __device__ __forceinline__ int perm32(int rho) { const int n = rho >> 4, i = rho & 15; return 8 * (i >> 2) + 4 * n + (i & 3); }

struct Unit { int pm, pn; };
struct Gemm { const bf16_t* A; const bf16_t* Bt; int M, N, K; };

struct StaticOrder {
    int nM, nN, nwg, G, c;
    __host__ __device__ void init(int M, int N, int G_, int c_) { nM = M / BM; nN = N / BM; nwg = nM * nN; G = G_; c = c_; }
    __host__ __device__ bool next(int i, Unit& u) const {
        const long L = (long)i * G + c; if (L >= nwg) return false;
        int wgid = (int)L; { const int q = nwg / NXCD, r = nwg % NXCD, xcd = wgid % NXCD, off = wgid / NXCD; wgid = (xcd < r ? xcd * (q + 1) : r * (q + 1) + (xcd - r) * q) + off; }
        const int nig = WGM * nN, gid = wgid / nig, fm = gid * WGM, gsz = (nM - fm) < WGM ? (nM - fm) : WGM;
        u.pm = fm + ((wgid % nig) % gsz); u.pn = (wgid % nig) / gsz; return true;
    }
    __device__ __forceinline__ void a_ready(const Unit&) const {}
    __device__ __forceinline__ void done(const Unit&) const {}
};

__device__ __forceinline__ unsigned cvt_pk_bf16(float lo, float hi) { unsigned r; asm volatile("v_cvt_pk_bf16_f32 %0, %1, %2" : "=v"(r) : "v"(lo), "v"(hi)); return r; }
template <class Epi, class Sched, bool ALIGN_EPI = false, bool SP2 = false>
__device__ __forceinline__ void gemm_phase(PG8_LAS unsigned char* lds, const Gemm g, const Sched& S, const Epi& E) {
    int tid_ = threadIdx.x; asm volatile("" : "+v"(tid_));
    const int tid = tid_, wid = __builtin_amdgcn_readfirstlane(tid >> 6), lane = tid & 63, wr = wid >> 2, wc = wid & 3, fr = lane & 15, fq = lane >> 4;
    const int K = g.K, nt = K / BK;
    unsigned voffA[2], voffB[2];
#pragma unroll
    for (int i = 0; i < 2; ++i) { int R, C; stage_rc(tid * 16 + i * 8192, R, C); const int Rb = Epi::PERM ? ((R & ~31) + perm32(R & 31)) : R;
        voffA[i] = (unsigned)(R * K + C) * 2u; voffB[i] = (unsigned)(Rb * K + C) * 2u; }
    const size_t kstep = (size_t)(BK * 2);
    const size_t hstep = (size_t)HALF * K * 2;
    const size_t tstep = 2 * hstep;
    const unsigned ldsw = (unsigned)wid * 1024u;
    const int aoff = lds_byte(wr * 64 + fr, fq * 8), boff = lds_byte(wc * 32 + fr, fq * 8);
#define PG8_SA(b, h) (((b) * 2 + (h)) * HTB)
#define PG8_SB(b, h) ((4 + (b) * 2 + (h)) * HTB)
#define PG8_STAGE(bufoff, gbase, voff) do { _Pragma("unroll") for (int _i = 0; _i < 2; ++_i) \
        __builtin_amdgcn_global_load_lds((const unsigned*)((const char*)(gbase) + (voff)[_i]), (PG8_LAS unsigned*)(lds + (bufoff) + ldsw + _i * 8192), 16, 0, 0); } while (0)
#define PG8_LDA(dst, b, h) do { _Pragma("unroll") for (int m = 0; m < 4; ++m) _Pragma("unroll") for (int k = 0; k < 2; ++k) dst[m][k] = *(const PG8_LAS bf16x8*)(lds + PG8_SA(b, h) + aoff + m * 2048 + k * 1024); } while (0)
#define PG8_LDB(dst, b, h) do { _Pragma("unroll") for (int n = 0; n < 2; ++n) _Pragma("unroll") for (int k = 0; k < 2; ++k) dst[n][k] = *(const PG8_LAS bf16x8*)(lds + PG8_SB(b, h) + boff + n * 2048 + k * 1024); } while (0)
#define PG8_MMA(ai, bj, At, Bt) do { __builtin_amdgcn_s_setprio(1); _Pragma("unroll") for (int m = 0; m < 4; ++m) _Pragma("unroll") for (int n = 0; n < 2; ++n) _Pragma("unroll") for (int k = 0; k < 2; ++k) \
        acc[ai][bj][m][n] = __builtin_amdgcn_mfma_f32_16x16x32_bf16(Bt[n][k], At[m][k], acc[ai][bj][m][n], 0, 0, 0); __builtin_amdgcn_s_setprio(0); } while (0)
#define PG8_WAIT_V(n) asm volatile("s_waitcnt vmcnt(" #n ")" ::: "memory")
#define PG8_WAIT_L(n) asm volatile("s_waitcnt lgkmcnt(" #n ")" ::: "memory")
#define PG8_BAR __builtin_amdgcn_s_barrier()
#define PG8_SCHED __builtin_amdgcn_sched_barrier(0)
    Unit cur, nxt; int ui = 0;
    if (!S.next(0, cur)) return;
    f32x4 acc[2][2][4][2];
#pragma unroll
    for (int a = 0; a < 2; ++a)
#pragma unroll
        for (int b = 0; b < 2; ++b)
#pragma unroll
            for (int m = 0; m < 4; ++m)
#pragma unroll
                for (int n = 0; n < 2; ++n) acc[a][b][m][n] = (f32x4){0.f, 0.f, 0.f, 0.f};
    bf16x8 At[4][2], B0[2][2], B1[2][2];
    const char* cA = (const char*)g.A + (size_t)cur.pm * tstep; const char* cB = (const char*)g.Bt + (size_t)cur.pn * tstep;
    S.a_ready(cur);
    if constexpr (SP2) {
        PG8_STAGE(PG8_SB(0, 0), cB, voffB); PG8_STAGE(PG8_SB(0, 1), cB + hstep, voffB); PG8_STAGE(PG8_SA(0, 0), cA, voffA); PG8_STAGE(PG8_SA(0, 1), cA + hstep, voffA);
        if (wr == 1) PG8_BAR;
        PG8_WAIT_V(2); PG8_BAR;
        PG8_STAGE(PG8_SB(1, 0), cB + kstep, voffB); PG8_STAGE(PG8_SA(1, 0), cA + kstep, voffA); PG8_STAGE(PG8_SB(1, 1), cB + hstep + kstep, voffB);
        PG8_WAIT_V(6); PG8_BAR;
    } else {
        PG8_STAGE(PG8_SB(0, 0), cB, voffB); PG8_STAGE(PG8_SA(0, 0), cA, voffA); PG8_STAGE(PG8_SB(0, 1), cB + hstep, voffB); PG8_STAGE(PG8_SA(0, 1), cA + hstep, voffA);
        if (wr == 1) PG8_BAR;
        PG8_WAIT_V(4); PG8_BAR;
        PG8_STAGE(PG8_SB(1, 0), cB + kstep, voffB); PG8_STAGE(PG8_SA(1, 0), cA + kstep, voffA); PG8_STAGE(PG8_SB(1, 1), cB + hstep + kstep, voffB);
        PG8_WAIT_V(6); PG8_BAR;
    }
    for (;;) {
        E.begin(cur, ui);
        const bool has_next = S.next(ui + 1, nxt);
        const char* nA = has_next ? (const char*)g.A + (size_t)nxt.pm * tstep : cA; const char* nB = has_next ? (const char*)g.Bt + (size_t)nxt.pn * tstep : cB;
        for (int t = 0; t < nt; t += 2) {
            if constexpr (Epi::MIDSCALE) { if (t == 8) E.mid(acc, cur, ui, wr, fr); }
            const bool last = (t == nt - 2);
            const char* a1 = cA + (size_t)(t + 1) * kstep;
            const char* a2 = last ? nA : cA + (size_t)(t + 2) * kstep; const char* b2 = last ? nB : cB + (size_t)(t + 2) * kstep;
            const char* a3 = a2 + kstep; const char* b3 = b2 + kstep;
            if (last && has_next) S.a_ready(nxt);
            if constexpr (SP2) {
            PG8_LDB(B0, 0, 0); PG8_LDB(B1, 0, 1); PG8_SCHED; PG8_LDA(At, 0, 0); PG8_STAGE(PG8_SA(1, 1), a1 + hstep, voffA);
            PG8_WAIT_V(8); PG8_WAIT_L(0); PG8_BAR; PG8_MMA(0, 0, At, B0); PG8_MMA(0, 1, At, B1); PG8_BAR; PG8_SCHED;
            PG8_LDA(At, 0, 1); PG8_STAGE(PG8_SB(0, 0), b2, voffB); PG8_STAGE(PG8_SB(0, 1), b2 + hstep, voffB); PG8_STAGE(PG8_SA(0, 0), a2, voffA);
            PG8_WAIT_V(8); PG8_WAIT_L(0); PG8_BAR; PG8_MMA(1, 0, At, B0); PG8_MMA(1, 1, At, B1); PG8_BAR; PG8_SCHED;
            PG8_LDB(B0, 1, 0); PG8_LDB(B1, 1, 1); PG8_SCHED; PG8_LDA(At, 1, 0); PG8_STAGE(PG8_SA(0, 1), a2 + hstep, voffA);
            PG8_WAIT_V(8); PG8_WAIT_L(0); PG8_BAR; PG8_MMA(0, 0, At, B0); PG8_MMA(0, 1, At, B1); PG8_BAR; PG8_SCHED;
            PG8_LDA(At, 1, 1); PG8_STAGE(PG8_SB(1, 0), b3, voffB); PG8_STAGE(PG8_SB(1, 1), b3 + hstep, voffB); PG8_STAGE(PG8_SA(1, 0), a3, voffA);
            PG8_WAIT_V(8); PG8_WAIT_L(0); PG8_BAR; PG8_MMA(1, 0, At, B0); PG8_MMA(1, 1, At, B1); PG8_BAR; PG8_SCHED;
            } else {
            PG8_LDB(B0, 0, 0); PG8_SCHED; PG8_LDA(At, 0, 0); PG8_STAGE(PG8_SA(1, 1), a1 + hstep, voffA);
            PG8_WAIT_L(8); PG8_BAR; PG8_WAIT_L(0); PG8_MMA(0, 0, At, B0); PG8_BAR; PG8_SCHED;
            PG8_LDB(B1, 0, 1); PG8_STAGE(PG8_SB(0, 0), b2, voffB);
            PG8_BAR; PG8_WAIT_L(0); PG8_MMA(0, 1, At, B1); PG8_BAR;
            PG8_LDA(At, 0, 1); PG8_STAGE(PG8_SA(0, 0), a2, voffA);
            PG8_BAR; PG8_WAIT_L(0); PG8_MMA(1, 0, At, B0); PG8_BAR; PG8_SCHED;
            PG8_STAGE(PG8_SB(0, 1), b2 + hstep, voffB);
            PG8_WAIT_V(6); PG8_BAR; PG8_MMA(1, 1, At, B1); PG8_BAR;
            PG8_LDB(B0, 1, 0); PG8_SCHED; PG8_LDA(At, 1, 0); PG8_STAGE(PG8_SA(0, 1), a2 + hstep, voffA);
            PG8_WAIT_L(8); PG8_BAR; PG8_WAIT_L(0); PG8_MMA(0, 0, At, B0); PG8_BAR; PG8_SCHED;
            PG8_LDB(B1, 1, 1); PG8_STAGE(PG8_SB(1, 0), b3, voffB);
            PG8_BAR; PG8_WAIT_L(0); PG8_MMA(0, 1, At, B1); PG8_BAR;
            PG8_LDA(At, 1, 1); PG8_STAGE(PG8_SA(1, 0), a3, voffA);
            PG8_BAR; PG8_WAIT_L(0); PG8_MMA(1, 0, At, B0); PG8_BAR; PG8_SCHED;
            PG8_STAGE(PG8_SB(1, 1), b3 + hstep, voffB);
            PG8_WAIT_V(6); PG8_BAR; PG8_MMA(1, 1, At, B1); PG8_BAR;
            }
        }
        if constexpr (ALIGN_EPI) { if (wr == 0) PG8_BAR; }
        if constexpr (!Epi::AFTER_DRAIN) { E(acc, cur, ui, wr, wc, fr, fq); S.done(cur); }
        if (!has_next) break;
#pragma unroll
        for (int a = 0; a < 2; ++a)
#pragma unroll
            for (int b = 0; b < 2; ++b)
#pragma unroll
                for (int m = 0; m < 4; ++m)
#pragma unroll
                    for (int n = 0; n < 2; ++n) acc[a][b][m][n] = (f32x4){0.f, 0.f, 0.f, 0.f};
        cur = nxt; cA = nA; cB = nB; ++ui;
        if constexpr (ALIGN_EPI) { if (wr == 1) PG8_BAR; }
    }
    PG8_WAIT_V(0);
    if constexpr (!ALIGN_EPI) { if (wr == 0) PG8_BAR; }
    PG8_BAR;
    if constexpr (Epi::AFTER_DRAIN) { E.fused(acc, cur, wr, wc, fr, fq, lds, wid, lane); S.done(cur); }
#undef PG8_SA
#undef PG8_SB
#undef PG8_STAGE
#undef PG8_LDA
#undef PG8_LDB
#undef PG8_MMA
#undef PG8_WAIT_V
#undef PG8_WAIT_L
#undef PG8_BAR
#undef PG8_SCHED
}
}

struct Args {
    const float* x_prompt; const float* x_sample; const float* c_fk; const float* c_fv; const float* c_fl; const float* c_sk; const float* c_sv;
    const float* norm_g; const float* w_in; const float* b_f; const float* gn_a; const float* gn_b; const float* w_out; const float* fin_g;
    float* out; unsigned char* ws; int ph_lo, ph_hi;
};
constexpr int NTHR = 512;
constexpr int LDS_BYTES = 147456;
constexpr int MISC_OFF = 131072 + 320;
constexpr int TAB_OFF = 131072 + 1024;
#ifndef FAST_GEMM
#define FAST_GEMM 1
#endif
#ifndef FAST_ATTN
#define FAST_ATTN 1
#endif
#ifndef PROBE_LEVEL
#define PROBE_LEVEL 3
#endif
#ifndef PROBE_DOUBLE
#define PROBE_DOUBLE 0
#endif

__device__ __forceinline__ int src_col(int n) {
    const int j = n >> 9, c = n & 511;
    const int off = (j == 0) ? 0 : (j == 1) ? 2056 : (j == 2) ? 512 : (j == 3) ? 2568 : (j == 4) ? 1024 : (j == 5) ? 3080 : (j == 6) ? 1544 : 3592;
    return off + c;
}
__device__ __forceinline__ void phase_prep(const Args& a, int gtid, int gthreads, LAS unsigned char* lds, int wave, int gwave, int nwaves, int lane) {
    bf16* win = (bf16*)(a.ws + WS_WIN); bf16* wout = (bf16*)(a.ws + WS_WOUT); float* wf = (float*)(a.ws + WS_WF);
    LAS float* tile = (LAS float*)(lds + wave * 8448);
    const int rn = lane & 31, rk = lane >> 5, wn = lane >> 3, wc = lane & 7;
    for (int item = gwave; item < 5120; item += nwaves) {
        const bool isin = item < 4096;
        const int it = isin ? item : item - 4096;
        const int l = isin ? (it >> 11) : (it >> 9);
        const int kb = isin ? ((it >> 7) & 15) : ((it >> 5) & 15);
        const int nb = isin ? (it & 127) : (it & 31);
        const float* src = isin ? a.w_in + ((size_t)l * D + kb * 64) * IN_DIM + src_col(nb * 32) + rn
                                : a.w_out + ((size_t)l * D + kb * 64) * D + nb * 32 + rn;
        const size_t sld = isin ? IN_DIM : D;
        float v[32];
#pragma unroll
        for (int r = 0; r < 32; ++r) v[r] = src[(size_t)(2 * r + rk) * sld];
#pragma unroll
        for (int r = 0; r < 32; ++r) tile[(2 * r + rk) * 33 + rn] = v[r];
        asm volatile("s_waitcnt lgkmcnt(0)" ::: "memory");
        float g[8];
        if (isin && l == 1) {
            const float4 g0 = *(const float4*)(a.norm_g + D + kb * 64 + wc * 8), g1 = *(const float4*)(a.norm_g + D + kb * 64 + wc * 8 + 4);
            g[0] = g0.x; g[1] = g0.y; g[2] = g0.z; g[3] = g0.w; g[4] = g1.x; g[5] = g1.y; g[6] = g1.z; g[7] = g1.w;
        } else {
#pragma unroll
            for (int j = 0; j < 8; ++j) g[j] = 1.0f;
        }
        bf16* dst = isin ? win + ((size_t)l * NPROJ + nb * 32) * D + kb * 64 + wc * 8
                         : wout + ((size_t)l * D + nb * 32) * D + kb * 64 + wc * 8;
#pragma unroll
        for (int p = 0; p < 4; ++p) {
            const int n = p * 8 + wn;
            float t[8];
#pragma unroll
            for (int j = 0; j < 8; ++j) t[j] = tile[(wc * 8 + j) * 33 + n] * g[j];
            uint4 o; o.x = pk2(t[0], t[1]); o.y = pk2(t[2], t[3]); o.z = pk2(t[4], t[5]); o.w = pk2(t[6], t[7]);
            *(uint4*)(dst + (size_t)n * D) = o;
        }
        asm volatile("s_waitcnt lgkmcnt(0)" ::: "memory");
    }
    for (int i = gtid; i < 2 * D * 8; i += gthreads) { const int j = i & 7, k = (i >> 3) & (D - 1), l = i >> 13; wf[i] = a.w_in[((size_t)l * D + k) * IN_DIM + 1536 + j] * ((l == 1) ? a.norm_g[D + k] : 1.0f); }
}

__device__ __forceinline__ float log_sigmoid_f(float x) { return -(fmaxf(-x, 0.f) + log1pf(expf(-fabsf(x)))); }
__device__ __forceinline__ void phase_norm(const Args& a, int l, int gwave, int nwaves, int lane) {
    bf16* hn = (bf16*)(a.ws + WS_HN); const float* xp = (const float*)(a.ws + WS_XP); const float* wf = (const float*)(a.ws + WS_WF) + (size_t)l * D * 8;
    const float* g = a.norm_g + (size_t)l * D;
    f32x4 wfr[4][4][2], gg[4];
#pragma unroll
    for (int j = 0; j < 4; ++j) { gg[j] = *(const f32x4*)(g + 4 * lane + 256 * j);
#pragma unroll
        for (int i = 0; i < 4; ++i) { const float* wr = a.w_in + ((size_t)l * D + 4 * lane + 256 * j + i) * IN_DIM + 1536;
            wfr[j][i][0] = *(const f32x4*)wr; wfr[j][i][1] = *(const f32x4*)(wr + 4); } }
    const float bfv = a.b_f[l * H + (lane >> 3)];
    for (int row = gwave; row < MT; row += nwaves) {
        const float* src = (l == 0) ? (row < MP ? a.x_prompt + (size_t)row * D : a.x_sample + (size_t)(row - MP) * D) : xp + (size_t)row * D;
        f32x4 v[4]; float s = 0.f;
#pragma unroll
        for (int j = 0; j < 4; ++j) { v[j] = *(const f32x4*)(src + 4 * lane + 256 * j); s += (v[j].x * v[j].x + v[j].y * v[j].y) + (v[j].z * v[j].z + v[j].w * v[j].w); }
        f32x4 f0 = {0.f, 0.f, 0.f, 0.f}, f1 = {0.f, 0.f, 0.f, 0.f};
#pragma unroll
        for (int j = 0; j < 4; ++j) { v[j] = v[j] * gg[j];
#pragma unroll
            for (int i = 0; i < 4; ++i) { f0 += wfr[j][i][0] * v[j][i]; f1 += wfr[j][i][1] * v[j][i]; } }
        s = wave_sum(s);
        const float k1 = gate_reduce(f0, f1, lane);
        const float rstd = 1.0f / sqrtf(s * (1.0f / D) + EPS);
#pragma unroll
        for (int j = 0; j < 4; ++j) { const f32x4 y = v[j] * rstd; u32x2 w; w.x = pk2(y.x, y.y); w.y = pk2(y.z, y.w); *(u32x2*)(hn + (size_t)row * D + 4 * lane + 256 * j) = w; }
        if ((lane & 7) == 0) {
            const float lf = log_sigmoid_f(k1 * rstd + bfv); const int q = lane >> 3;
            if (row < MP) a.out[O_FLP + ((size_t)l * MP + row) * H + q] = lf;
            else a.out[O_FLS + ((size_t)l * MS + (row - MP)) * H + q] = lf;
        }
    }
}

__device__ __forceinline__ void phase_stats1(const Args& a, int gwave, int nwaves, int lane) {
    const bf16* xb = (const bf16*)(a.ws + WS_XP); const float* wf = (const float*)(a.ws + WS_WF) + (size_t)D * 8; float* rstd_o = (float*)(a.ws + WS_RSTD);
    f32x4 wfr[16][2];
#pragma unroll
    for (int i = 0; i < 16; ++i) { const float* wr = wf + (size_t)(16 * lane + i) * 8; wfr[i][0] = *(const f32x4*)wr; wfr[i][1] = *(const f32x4*)(wr + 4); }
    const float bfv_ = a.b_f[H + (lane >> 3)];
#pragma unroll
    for (int i = 0; i < 16; ++i) asm volatile("" : "+v"(wfr[i][0]), "+v"(wfr[i][1]));
    float bfv = bfv_; asm volatile("" : "+v"(bfv));
    u32x4 n0, n1;
    { const bf16* p0 = xb + (size_t)(gwave < MT ? gwave : 0) * D + 16 * lane;
      asm volatile("global_load_dwordx4 %0, %2, off\n\tglobal_load_dwordx4 %1, %2, off offset:16" : "=&v"(n0), "=&v"(n1) : "v"(p0) : "memory");
      asm volatile("s_waitcnt vmcnt(0)" : "+v"(n0), "+v"(n1) :: "memory"); }
    for (int row = gwave; row < MT; row += nwaves) {
        const u32x4 w0 = n0, w1 = n1;
        { const int nr = (row + nwaves < MT) ? row + nwaves : row;
          const bf16* p0 = xb + (size_t)nr * D + 16 * lane;
          asm volatile("global_load_dwordx4 %0, %2, off\n\tglobal_load_dwordx4 %1, %2, off offset:16" : "=&v"(n0), "=&v"(n1) : "v"(p0) : "memory"); }
        const float v[16] = {bflo(w0.x), bfhi(w0.x), bflo(w0.y), bfhi(w0.y), bflo(w0.z), bfhi(w0.z), bflo(w0.w), bfhi(w0.w),
                             bflo(w1.x), bfhi(w1.x), bflo(w1.y), bfhi(w1.y), bflo(w1.z), bfhi(w1.z), bflo(w1.w), bfhi(w1.w)};
        float s = 0.f; f32x4 f0 = {0.f, 0.f, 0.f, 0.f}, f1 = {0.f, 0.f, 0.f, 0.f};
#pragma unroll
        for (int i = 0; i < 16; ++i) { s += v[i] * v[i]; f0 += wfr[i][0] * v[i]; f1 += wfr[i][1] * v[i]; }
        s = wave_sum(s);
        const float k1 = gate_reduce(f0, f1, lane);
        const float rstd = 1.0f / sqrtf(s * (1.0f / D) + EPS);
        if (lane == 0) rstd_o[row] = rstd;
        if ((lane & 7) == 0) {
            const float lf = log_sigmoid_f(k1 * rstd + bfv); const int q = lane >> 3;
            if (row < MP) a.out[O_FLP + ((size_t)MP + row) * H + q] = lf;
            else a.out[O_FLS + ((size_t)MS + (row - MP)) * H + q] = lf;
        }
        asm volatile("s_waitcnt vmcnt(2)" : "+v"(n0), "+v"(n1) :: "memory");
    }
}

template <int E>
__device__ __forceinline__ void cumsum_wg(const float* src, float* dst, int dstride, f32x4 c0, f32x4 c1, LAS float* tot, int wave, int lane) {
    const int t0 = (wave * 64 + lane) * E;
    f32x4 v[E][2];
#pragma unroll
    for (int i = 0; i < E; ++i) { v[i][0] = *(const f32x4*)(src + (size_t)(t0 + i) * 8); v[i][1] = *(const f32x4*)(src + (size_t)(t0 + i) * 8 + 4); }
    f32x4 r0 = {0.f, 0.f, 0.f, 0.f}, r1 = {0.f, 0.f, 0.f, 0.f};
#pragma unroll
    for (int i = E - 1; i >= 0; --i) { const f32x4 x0 = v[i][0], x1 = v[i][1]; v[i][0] = r0; v[i][1] = r1; r0 += x0; r1 += x1; }
    f32x4 p0 = r0, p1 = r1;
#pragma unroll
    for (int o = 1; o < 64; o <<= 1) {
        f32x4 q0, q1;
#pragma unroll
        for (int j = 0; j < 4; ++j) { q0[j] = __shfl_down(p0[j], o); q1[j] = __shfl_down(p1[j], o); }
        if (lane + o < 64) { p0 += q0; p1 += q1; }
    }
    f32x4 e0, e1;
#pragma unroll
    for (int j = 0; j < 4; ++j) { const float a0 = __shfl_down(p0[j], 1), a1 = __shfl_down(p1[j], 1); e0[j] = lane < 63 ? a0 : 0.f; e1[j] = lane < 63 ? a1 : 0.f; }
    if (lane == 0) { *(LAS f32x4*)(tot + wave * 8) = p0; *(LAS f32x4*)(tot + wave * 8 + 4) = p1; }
    __syncthreads();
#pragma unroll
    for (int w = 1; w < 8; ++w) if (w > wave) { c0 += *(const LAS f32x4*)(tot + w * 8); c1 += *(const LAS f32x4*)(tot + w * 8 + 4); }
    __syncthreads();
    e0 += c0; e1 += c1;
#pragma unroll
    for (int j = 0; j < 4; ++j)
#pragma unroll
        for (int i0 = 0; i0 < E; i0 += 4) {
            f32x4 o0, o1;
#pragma unroll
            for (int i = 0; i < 4; ++i) { o0[i] = (e0[j] + v[i0 + i][0][j]) * LOG2E; o1[i] = (e1[j] + v[i0 + i][1][j]) * LOG2E; }
            *(f32x4*)(dst + (size_t)j * dstride + t0 + i0) = o0; *(f32x4*)(dst + (size_t)(4 + j) * dstride + t0 + i0) = o1;
        }
}
__device__ __forceinline__ void phase_cumsum(const Args& a, int l, LAS unsigned char* lds, int blk, int wave, int lane) {
    if (blk >= NB + DB) return;
    LAS float* tot = (LAS float*)lds;
    const f32x4 z = {0.f, 0.f, 0.f, 0.f};
    if (blk < NB) {
        const int b = blk;
        cumsum_wg<4>(a.out + O_FLP + ((size_t)l * MP + (size_t)b * T) * H, (float*)(a.ws + WS_CKP) + (size_t)(b * 8) * T, T, z, z, tot, wave, lane);
    } else {
        const int b = blk - NB;
        float* cks = (float*)(a.ws + WS_CKS) + (size_t)(b * 8) * SKV;
        f32x4 p0 = z, p1 = z;
        if (lane < DT) { const float* tp = a.out + O_FLS + ((size_t)l * MS + b * DT + lane) * H; p0 = *(const f32x4*)tp; p1 = *(const f32x4*)(tp + 4); }
#pragma unroll
        for (int o = 1; o < DT; o <<= 1) {
            f32x4 q0, q1;
#pragma unroll
            for (int j = 0; j < 4; ++j) { q0[j] = __shfl_down(p0[j], o); q1[j] = __shfl_down(p1[j], o); }
            if (lane + o < DT) { p0 += q0; p1 += q1; }
        }
        f32x4 c0, c1, e0, e1;
#pragma unroll
        for (int j = 0; j < 4; ++j) { c0[j] = __shfl(p0[j], 0); c1[j] = __shfl(p1[j], 0); const float a0 = __shfl_down(p0[j], 1), a1 = __shfl_down(p1[j], 1); e0[j] = a0; e1[j] = a1; }
        if (wave == 0 && lane < DT) {
#pragma unroll
            for (int j = 0; j < 4; ++j) { cks[(size_t)j * SKV + PAST + lane] = (lane < DT - 1 ? e0[j] : 0.f) * LOG2E; cks[(size_t)(4 + j) * SKV + PAST + lane] = (lane < DT - 1 ? e1[j] : 0.f) * LOG2E; }
        }
        cumsum_wg<8>(a.c_fl + ((size_t)l * DB + b) * PAST * H, cks, SKV, c0, c1, tot, wave, lane);
    }
    __syncthreads();
}

struct EpiInProj {
    static constexpr bool PERM = true, AFTER_DRAIN = false, MIDSCALE = false;
    int l; bf16 *qb, *kb, *vb, *zb; float* out; const float* rstd;
    __device__ __forceinline__ void begin(const pg8::Unit&, int) const {}
    __device__ __forceinline__ void operator()(const pg8::f32x4 (&acc_)[2][2][4][2], const pg8::Unit& u, int, int wr, int wc, int fr, int fq) const {
        const int kind = u.pn >> 2, cc0 = (u.pn & 3) * 256 + wc * 32 + 8 * fq;
        const bool samp = (u.pm == MP / 256);
        bf16* bbuf = kind == 0 ? qb : kind == 1 ? kb : kind == 2 ? vb : zb;
        const float sc = kind == 0 ? C2 : 1.0f;
        pg8::f32x4 acc[2][2][4][2];
#pragma unroll
        for (int ai = 0; ai < 2; ++ai)
#pragma unroll
            for (int m = 0; m < 4; ++m) { const float rs = rstd ? rstd[u.pm * 256 + ai * 128 + wr * 64 + m * 16 + fr] : 1.0f;
#pragma unroll
                for (int bj = 0; bj < 2; ++bj)
#pragma unroll
                    for (int n = 0; n < 2; ++n) acc[ai][bj][m][n] = acc_[ai][bj][m][n] * rs; }
#pragma unroll
        for (int ai = 0; ai < 2; ++ai)
#pragma unroll
            for (int m = 0; m < 4; ++m) {
                const int grow = u.pm * 256 + ai * 128 + wr * 64 + m * 16 + fr;
#pragma unroll
                for (int bj = 0; bj < 2; ++bj) {
                    const int cc = cc0 + bj * 128;
                    const pg8::f32x4 v0 = acc[ai][bj][m][0], v1 = acc[ai][bj][m][1];
                    u32x4 w; w.x = pg8::cvt_pk_bf16(v0[0] * sc, v0[1] * sc); w.y = pg8::cvt_pk_bf16(v0[2] * sc, v0[3] * sc); w.z = pg8::cvt_pk_bf16(v1[0] * sc, v1[1] * sc); w.w = pg8::cvt_pk_bf16(v1[2] * sc, v1[3] * sc);
                    *(u32x4*)(bbuf + (size_t)grow * D + cc) = w;
                    if (out && (kind == 1 || kind == 2)) {
                        const bool grpB = cc >= W; const int c5 = cc & (W - 1);
                        size_t o;
                        if (!samp) o = (kind == 1 ? (grpB ? O_SKP : O_FKP) : (grpB ? O_SVP : O_FVP)) + ((size_t)l * MP + grow) * W + c5;
                        else o = (kind == 1 ? (grpB ? O_SKS : O_FKS) : (grpB ? O_SVS : O_FVS)) + ((size_t)l * MS + (grow - MP)) * W + c5;
                        *(pg8::f32x4*)(out + o) = v0; *(pg8::f32x4*)(out + o + 4) = v1;
                    }
                }
            }
    }
};
struct EpiOutProj {
    static constexpr bool PERM = true, AFTER_DRAIN = false, MIDSCALE = true;
    int l; const float* xin_p; const float* xin_s; const float* ssq; float* xp; LAS float* tab;
    __device__ __forceinline__ void begin(const pg8::Unit& u, int ui) const {
        const int tid = threadIdx.x;
        if (tid < 256) {
            const float* sq = ssq + (size_t)(u.pm * 256 + tid) * 16;
            const pg8::f32x4 a0 = *(const pg8::f32x4*)sq, a1 = *(const pg8::f32x4*)(sq + 4), b0 = *(const pg8::f32x4*)(sq + 8), b1 = *(const pg8::f32x4*)(sq + 12);
            const float sa = ((a0[0] + a0[1]) + (a0[2] + a0[3])) + ((a1[0] + a1[1]) + (a1[2] + a1[3]));
            const float sb = ((b0[0] + b0[1]) + (b0[2] + b0[3])) + ((b1[0] + b1[1]) + (b1[2] + b1[3]));
            const float rA = 1.0f / sqrtf(sa * (1.0f / W) + EPS), rB = 1.0f / sqrtf(sb * (1.0f / W) + EPS);
            LAS float* t = tab + ((ui & 1) * 256 + tid) * 2; t[0] = rA / rB; t[1] = rB;
        }
    }
    __device__ __forceinline__ void mid(pg8::f32x4 (&acc)[2][2][4][2], const pg8::Unit&, int ui, int wr, int fr) const {
#pragma unroll
        for (int ai = 0; ai < 2; ++ai)
#pragma unroll
            for (int m = 0; m < 4; ++m) {
                const float ratio = tab[((ui & 1) * 256 + ai * 128 + wr * 64 + m * 16 + fr) * 2];
#pragma unroll
                for (int bj = 0; bj < 2; ++bj)
#pragma unroll
                    for (int n = 0; n < 2; ++n) acc[ai][bj][m][n] *= ratio;
            }
    }
    __device__ __forceinline__ void operator()(const pg8::f32x4 (&acc)[2][2][4][2], const pg8::Unit& u, int ui, int wr, int wc, int fr, int fq) const {
        const size_t off0 = ((size_t)u.pm * 256 + wr * 64 + fr) * D + u.pn * 256 + wc * 32 + 8 * fq;
        const LAS float* tb = tab + ((ui & 1) * 256 + wr * 64 + fr) * 2 + 1;
        bf16* xb = (bf16*)xp;
#pragma unroll
        for (int ai = 0; ai < 2; ++ai) {
            pg8::f32x4 x[4][2][2];
#pragma unroll
            for (int m = 0; m < 4; ++m) { const size_t ro = off0 + (size_t)(ai * 128 + m * 16) * D;
#pragma unroll
                for (int bj = 0; bj < 2; ++bj) {
                    if (l == 0) { x[m][bj][0] = *(const pg8::f32x4*)(xin_p + ro + bj * 128); x[m][bj][1] = *(const pg8::f32x4*)(xin_p + ro + bj * 128 + 4); }
                    else { const u32x4 w = *(const u32x4*)(xb + ro + bj * 128);
                           x[m][bj][0] = (pg8::f32x4){bflo(w.x), bfhi(w.x), bflo(w.y), bfhi(w.y)}; x[m][bj][1] = (pg8::f32x4){bflo(w.z), bfhi(w.z), bflo(w.w), bfhi(w.w)}; } } }
#pragma unroll
            for (int m = 0; m < 4; ++m) { const size_t ro = off0 + (size_t)(ai * 128 + m * 16) * D; const float rB = tb[(ai * 128 + m * 16) * 2];
#pragma unroll
                for (int bj = 0; bj < 2; ++bj) {
                    const pg8::f32x4 y0 = x[m][bj][0] + acc[ai][bj][m][0] * rB, y1 = x[m][bj][1] + acc[ai][bj][m][1] * rB;
                    u32x4 o; o.x = pg8::cvt_pk_bf16(y0[0], y0[1]); o.y = pg8::cvt_pk_bf16(y0[2], y0[3]); o.z = pg8::cvt_pk_bf16(y1[0], y1[1]); o.w = pg8::cvt_pk_bf16(y1[2], y1[3]);
                    *(u32x4*)(xb + ro + bj * 128) = o; } }
            asm volatile("" ::: "memory");
        }
    }
};

typedef short sg_bf16x8 __attribute__((ext_vector_type(8)));
template <bool SPLIT, class Epi>
__device__ __forceinline__ void small_gemm(const bf16* A  , const bf16* Bt  , int N, const Epi& E, int unit) {
    int tid_ = threadIdx.x; asm volatile("" : "+v"(tid_));
    const int tid = tid_, lane = tid & 63, wid = __builtin_amdgcn_readfirstlane(tid >> 6), wr = wid >> 1, wc = wid & 1;
    if (unit >= 4 * (N / 64)) return;
    const int tm = unit & 3, tn = unit >> 2;
    const int row = tm * 64 + wr * 16 + (lane & 15), n0 = tn * 64 + wc * 32, kq = 8 * (lane >> 4);
    const bf16* xa = A + (size_t)row * D + kq;
    const bf16* w0 = Bt + (size_t)(n0 + (lane & 15)) * D + kq; const bf16* w1 = w0 + (size_t)16 * D;
    f32x4 acc[2][2];
#pragma unroll
    for (int i = 0; i < 2; ++i)
#pragma unroll
        for (int j = 0; j < 2; ++j) acc[i][j] = (f32x4){0.f, 0.f, 0.f, 0.f};
#pragma unroll 1
    for (int k0 = 0; k0 < D; k0 += 512) {
        sg_bf16x8 xf[16], wf0[16], wf1[16];
#pragma unroll
        for (int i = 0; i < 16; ++i) { xf[i] = *(const sg_bf16x8*)(xa + k0 + 32 * i); wf0[i] = *(const sg_bf16x8*)(w0 + k0 + 32 * i); wf1[i] = *(const sg_bf16x8*)(w1 + k0 + 32 * i); }
        const int hsel = (SPLIT && k0 >= 512) ? 1 : 0;
#pragma unroll
        for (int i = 0; i < 16; ++i) {
            if (hsel) { acc[1][0] = __builtin_amdgcn_mfma_f32_16x16x32_bf16(wf0[i], xf[i], acc[1][0], 0, 0, 0); acc[1][1] = __builtin_amdgcn_mfma_f32_16x16x32_bf16(wf1[i], xf[i], acc[1][1], 0, 0, 0); }
            else { acc[0][0] = __builtin_amdgcn_mfma_f32_16x16x32_bf16(wf0[i], xf[i], acc[0][0], 0, 0, 0); acc[0][1] = __builtin_amdgcn_mfma_f32_16x16x32_bf16(wf1[i], xf[i], acc[0][1], 0, 0, 0); }
        }
    }
#pragma unroll
    for (int t = 0; t < 2; ++t) E(row, n0 + 16 * t + 4 * (lane >> 4), acc[0][t], acc[1][t]);
}
struct EpiInS {
    int l; bf16 *qb, *kb, *vb, *zb; float* out; const float* rstd;
    __device__ __forceinline__ void operator()(int row, int n, const f32x4& c_, const f32x4&) const {
        const int kind = n >> 10, cc = n & 1023; const size_t grow = (size_t)MP + row;
        const f32x4 c = c_ * (rstd ? rstd[grow] : 1.0f);
        u32x2 w;
        if (kind == 0) { w.x = pk2(c[0] * C2, c[1] * C2); w.y = pk2(c[2] * C2, c[3] * C2); *(u32x2*)(qb + grow * D + cc) = w; return; }
        w.x = pk2(c[0], c[1]); w.y = pk2(c[2], c[3]);
        if (kind == 3) { *(u32x2*)(zb + grow * D + cc) = w; return; }
        *(u32x2*)((kind == 1 ? kb : vb) + grow * D + cc) = w;
        const bool grpB = cc >= W; const int c5 = cc & (W - 1);
        const size_t o = (kind == 1 ? (grpB ? O_SKS : O_FKS) : (grpB ? O_SVS : O_FVS)) + ((size_t)l * MS + row) * W + c5;
        *(f32x4*)(out + o) = c;
    }
};
struct EpiOutS {
    int l; const float* xin_s; const float* ssq; float* xp;
    __device__ __forceinline__ void operator()(int row, int n, const f32x4& ca, const f32x4& cb) const {
        const size_t grow = (size_t)MP + row;
        const float* sq = ssq + grow * 16; float sa = 0.f, sb = 0.f;
#pragma unroll
        for (int h = 0; h < 8; ++h) { sa += sq[h]; sb += sq[8 + h]; }
        const float rA = 1.0f / sqrtf(sa * (1.0f / W) + EPS), rB = 1.0f / sqrtf(sb * (1.0f / W) + EPS);
        bf16* xb = (bf16*)xp; f32x4 xv;
        if (l == 0) xv = *(const f32x4*)(xin_s + (size_t)row * D + n);
        else { const u32x2 w = *(const u32x2*)(xb + grow * D + n); xv = (f32x4){bflo(w.x), bfhi(w.x), bflo(w.y), bfhi(w.y)}; }
        const f32x4 y = xv + ca * rA + cb * rB;
        u32x2 o; o.x = pk2(y[0], y[1]); o.y = pk2(y[2], y[3]); *(u32x2*)(xb + grow * D + n) = o;
    }
};

template <bool SPLIT, class Epi>
__device__ __forceinline__ void naive_gemm(LAS unsigned char* lds, const bf16* A, const bf16* Bt, int M, int N, int K, const Epi& E, int blk, int nblk) {
    LAS float* As = (LAS float*)lds;
    LAS float* Bs = (LAS float*)(lds + 16 * 132 * 4);
    const int tid = threadIdx.x, tx = tid & 15, ty = tid >> 4;
    const int ntm = M / 128, ntn = N / 64;
    for (int tile = blk; tile < ntm * ntn; tile += nblk) {
        const int tm = tile / ntn, tn = tile % ntn, m0 = tm * 128, n0 = tn * 64;
        float acc[4][4], acc2[4][4];
#pragma unroll
        for (int i = 0; i < 4; ++i)
#pragma unroll
            for (int j = 0; j < 4; ++j) { acc[i][j] = 0.f; acc2[i][j] = 0.f; }
        for (int k0 = 0; k0 < K; k0 += 16) {
            { const int r = tid >> 2, kq = (tid & 3) * 4; const u32x2 w = *(const u32x2*)(A + (size_t)(m0 + r) * K + k0 + kq);
              As[(kq + 0) * 132 + r] = bflo(w.x); As[(kq + 1) * 132 + r] = bfhi(w.x); As[(kq + 2) * 132 + r] = bflo(w.y); As[(kq + 3) * 132 + r] = bfhi(w.y); }
            if (tid < 256) { const int r = tid >> 2, kq = (tid & 3) * 4; const u32x2 w = *(const u32x2*)(Bt + (size_t)(n0 + r) * K + k0 + kq);
              Bs[(kq + 0) * 68 + r] = bflo(w.x); Bs[(kq + 1) * 68 + r] = bfhi(w.x); Bs[(kq + 2) * 68 + r] = bflo(w.y); Bs[(kq + 3) * 68 + r] = bfhi(w.y); }
            __syncthreads();
            const bool second = SPLIT && (k0 >= 512);
#pragma unroll
            for (int kk = 0; kk < 16; ++kk) {
                const f32x4 av = *(const LAS f32x4*)(As + kk * 132 + ty * 4), bv = *(const LAS f32x4*)(Bs + kk * 68 + tx * 4);
                if (second) {
#pragma unroll
                    for (int i = 0; i < 4; ++i)
#pragma unroll
                        for (int j = 0; j < 4; ++j) acc2[i][j] += av[i] * bv[j];
                } else {
#pragma unroll
                    for (int i = 0; i < 4; ++i)
#pragma unroll
                        for (int j = 0; j < 4; ++j) acc[i][j] += av[i] * bv[j];
                }
            }
            __syncthreads();
        }
#pragma unroll
        for (int i = 0; i < 4; ++i) E(m0 + ty * 4 + i, n0 + tx * 4, acc[i], acc2[i]);
    }
}
struct EpiIn {
    int l; bf16 *qb, *kb, *vb, *zb; float* out;
    __device__ __forceinline__ void operator()(int row, int n, const float (&c)[4], const float (&)[4]) const {
        const int j = n >> 9, cc = n & 1023;
        const int kind = n >> 10;
        u32x2 w;
        if (kind == 0) { w.x = pk2(c[0] * C2, c[1] * C2); w.y = pk2(c[2] * C2, c[3] * C2); *(u32x2*)(qb + (size_t)row * D + cc) = w; return; }
        w.x = pk2(c[0], c[1]); w.y = pk2(c[2], c[3]);
        if (kind == 3) { *(u32x2*)(zb + (size_t)row * D + cc) = w; return; }
        *(u32x2*)((kind == 1 ? kb : vb) + (size_t)row * D + cc) = w;
        const bool grpB = (j & 1); const int c5 = n & 511;
        size_t o;
        if (row < MP) o = (kind == 1 ? (grpB ? O_SKP : O_FKP) : (grpB ? O_SVP : O_FVP)) + ((size_t)l * MP + row) * W + c5;
        else o = (kind == 1 ? (grpB ? O_SKS : O_FKS) : (grpB ? O_SVS : O_FVS)) + ((size_t)l * MS + (row - MP)) * W + c5;
        *(f32x4*)(out + o) = (f32x4){c[0], c[1], c[2], c[3]};
    }
};
struct EpiOut {
    int l; const float* xin_p; const float* xin_s; const float* ssq; float* xp;
    __device__ __forceinline__ void operator()(int row, int n, const float (&ca)[4], const float (&cb)[4]) const {
        const float* sq = ssq + (size_t)row * 16; float sa = 0.f, sb = 0.f;
#pragma unroll
        for (int h = 0; h < 8; ++h) { sa += sq[h]; sb += sq[8 + h]; }
        const float rA = 1.0f / sqrtf(sa * (1.0f / W) + EPS), rB = 1.0f / sqrtf(sb * (1.0f / W) + EPS);
        const float* xin = (l == 0) ? (row < MP ? xin_p + (size_t)row * D : xin_s + (size_t)(row - MP) * D) : xp + (size_t)row * D;
        const f32x4 xv = *(const f32x4*)(xin + n);
        f32x4 o;
#pragma unroll
        for (int i = 0; i < 4; ++i) o[i] = xv[i] + rA * ca[i] + rB * cb[i];
        *(f32x4*)(xp + (size_t)row * D + n) = o;
    }
};

__device__ __forceinline__ float silu_f(float z) { return z / (1.0f + expf(-z)); }
template <int NE> __device__ __forceinline__ void load_row_bf16(const bf16* p, float (&v)[NE]) {
#pragma unroll
    for (int c = 0; c < NE / 8; ++c) { const u32x4 w = *(const u32x4*)(p + 8 * c);
        v[8 * c + 0] = bflo(w.x); v[8 * c + 1] = bfhi(w.x); v[8 * c + 2] = bflo(w.y); v[8 * c + 3] = bfhi(w.y);
        v[8 * c + 4] = bflo(w.z); v[8 * c + 5] = bfhi(w.z); v[8 * c + 6] = bflo(w.w); v[8 * c + 7] = bfhi(w.w); }
}
template <int NE> __device__ __forceinline__ float dot_row_bf16(const bf16* p, const float (&q)[NE]) {
    float s0 = 0.f, s1 = 0.f;
#pragma unroll
    for (int c = 0; c < NE / 8; ++c) { if ((c & 3) == 0) asm volatile("" ::: "memory"); const u32x4 w = *(const u32x4*)(p + 8 * c);
        s0 += q[8 * c + 0] * bflo(w.x); s1 += q[8 * c + 1] * bfhi(w.x); s0 += q[8 * c + 2] * bflo(w.y); s1 += q[8 * c + 3] * bfhi(w.y);
        s0 += q[8 * c + 4] * bflo(w.z); s1 += q[8 * c + 5] * bfhi(w.z); s0 += q[8 * c + 6] * bflo(w.w); s1 += q[8 * c + 7] * bfhi(w.w); }
    return s0 + s1;
}
template <int NE> __device__ __forceinline__ void axpy_row_bf16(const bf16* p, float a, float (&o)[NE]) {
#pragma unroll
    for (int c = 0; c < NE / 8; ++c) { if ((c & 3) == 0) asm volatile("" ::: "memory"); const u32x4 w = *(const u32x4*)(p + 8 * c);
        o[8 * c + 0] += a * bflo(w.x); o[8 * c + 1] += a * bfhi(w.x); o[8 * c + 2] += a * bflo(w.y); o[8 * c + 3] += a * bfhi(w.y);
        o[8 * c + 4] += a * bflo(w.z); o[8 * c + 5] += a * bfhi(w.z); o[8 * c + 6] += a * bflo(w.w); o[8 * c + 7] += a * bfhi(w.w); }
}
__device__ __forceinline__ float rbf(float x) { return bf2f(f2bf(x)); }
template <int NE> __device__ __forceinline__ float dot_row_f32(const float* p, const float (&q)[NE]) {
    float s0 = 0.f, s1 = 0.f;
#pragma unroll
    for (int c = 0; c < NE / 4; ++c) { if ((c & 3) == 0) asm volatile("" ::: "memory"); const f32x4 w = *(const f32x4*)(p + 4 * c);
        s0 += q[4 * c + 0] * rbf(w.x); s1 += q[4 * c + 1] * rbf(w.y); s0 += q[4 * c + 2] * rbf(w.z); s1 += q[4 * c + 3] * rbf(w.w); }
    return s0 + s1;
}
template <int NE> __device__ __forceinline__ void axpy_row_f32(const float* p, float a, float (&o)[NE]) {
#pragma unroll
    for (int c = 0; c < NE / 4; ++c) { if ((c & 3) == 0) asm volatile("" ::: "memory"); const f32x4 w = *(const f32x4*)(p + 4 * c);
        o[4 * c + 0] += a * rbf(w.x); o[4 * c + 1] += a * rbf(w.y); o[4 * c + 2] += a * rbf(w.z); o[4 * c + 3] += a * rbf(w.w); }
}
template <int NE> __device__ __forceinline__ float gate_store(const Args& a, int l, int g, int colg, int row, const float (&o)[NE]) {
    const bf16* zb = (const bf16*)(a.ws + WS_Z) + (size_t)row * D + g * W + colg;
    bf16* og = (bf16*)(a.ws + WS_HN) + (size_t)row * D + g * W + colg;
    const float* gn = (g == 0 ? a.gn_a : a.gn_b) + (size_t)l * W + colg;
    float ssq = 0.f;
#pragma unroll
    for (int c = 0; c < NE / 8; ++c) { float r[8]; asm volatile("" ::: "memory");
        const u32x4 zw = *(const u32x4*)(zb + 8 * c);
        const float zz[8] = {bflo(zw.x), bfhi(zw.x), bflo(zw.y), bfhi(zw.y), bflo(zw.z), bfhi(zw.z), bflo(zw.w), bfhi(zw.w)};
#pragma unroll
        for (int i = 0; i < 8; ++i) { const float ov = o[8 * c + i]; ssq += ov * ov; r[i] = ov * gn[8 * c + i] * silu_f(zz[i]); }
        u32x4 w; w.x = pk2(r[0], r[1]); w.y = pk2(r[2], r[3]); w.z = pk2(r[4], r[5]); w.w = pk2(r[6], r[7]);
        *(u32x4*)(og + 8 * c) = w; }
    return ssq;
}
__device__ __forceinline__ float sb_logsig_neg2(float z2) {
    return -(fmaxf(z2, 0.f) + __log2f(1.0f + exp2f(-fabsf(z2))));
}
__device__ __forceinline__ float rhalf(float x) { return (float)(_Float16)x; }
__device__ __forceinline__ void attn_prompt_naive(const Args& a, int l, int gtid, int gthreads) {
    const bf16* qb = (const bf16*)(a.ws + WS_Q); const bf16* kb = (const bf16*)(a.ws + WS_K); const bf16* vb = (const bf16*)(a.ws + WS_V);
    const float* ckp = (const float*)(a.ws + WS_CKP);
    for (int it = gtid; it < 2 * NB * H * T; it += gthreads) {
        const int t = it & (T - 1), h = (it >> 11) & 7, b = (it >> 14) & 31, g = it >> 19;
        const int row = b * T + t, col = g * W + h * HD;
        float q[64], o[64]; load_row_bf16<64>(qb + (size_t)row * D + col, q);
#pragma unroll
        for (int d = 0; d < 64; ++d) o[d] = 0.f;
        const bf16* kp = kb + (size_t)b * T * D + col; const bf16* vp = vb + (size_t)b * T * D + col;
        const int tmax = t | 63;
        if (g == 0) {
            const float* ck = ckp + (size_t)(b * 8 + h) * T;
            float m = -1e30f, lsum = 0.f;
            for (int s = 0; s <= tmax; ++s) {
                const float x = dot_row_bf16<64>(kp + (size_t)s * D, q) + ck[s];
                if (s <= t) {
                    const float mn = fmaxf(m, x), al = exp2f(m - mn), p = exp2f(x - mn);
                    lsum = lsum * al + p; m = mn;
#pragma unroll
                    for (int d = 0; d < 64; ++d) o[d] *= al;
                    axpy_row_bf16<64>(vp + (size_t)s * D, rbf(p), o);
                }
            }
            const float inv = 1.0f / lsum;
#pragma unroll
            for (int d = 0; d < 64; ++d) o[d] *= inv;
        } else {
            float R = 0.f;
            for (int s = tmax - 1; s >= 0; --s) {
                const float z2 = dot_row_bf16<64>(kp + (size_t)s * D, q);
                if (s < t) {
                    const float L2 = sb_logsig_neg2(z2), A = exp2f(z2 + L2 + R);
                    axpy_row_bf16<64>(vp + (size_t)s * D, rbf(A), o);
                    R += rhalf(L2);
                }
            }
        }
        const float ssq = gate_store<64>(a, l, g, h * HD, row, o);
        ((float*)(a.ws + WS_SSQ))[(size_t)row * 16 + g * 8 + h] = ssq;
    }
}
__device__ __forceinline__ void attn_sample_naive(const Args& a, int l, int gtid, int gthreads) {
    const bf16* qb = (const bf16*)(a.ws + WS_Q); const bf16* kb = (const bf16*)(a.ws + WS_K); const bf16* vb = (const bf16*)(a.ws + WS_V);
    const float* cks = (const float*)(a.ws + WS_CKS);
    for (int it2 = gtid; it2 < 2 * 2 * DB * H * DT; it2 += gthreads) {
        const int hf = it2 & 1, it = it2 >> 1;
        const int t = it & 15, h = (it >> 4) & 7, b = (it >> 7) & 15, g = it >> 11;
        const int row = MP + b * DT + t, col = g * W + h * HD + hf * 32;
        float q[32], o[32]; load_row_bf16<32>(qb + (size_t)row * D + col, q);
#pragma unroll
        for (int d = 0; d < 32; ++d) o[d] = 0.f;
        const float* ck_c = (g == 0 ? a.c_fk : a.c_sk) + (((size_t)l * DB + b) * PAST) * W + h * HD + hf * 32;
        const float* cv_c = (g == 0 ? a.c_fv : a.c_sv) + (((size_t)l * DB + b) * PAST) * W + h * HD + hf * 32;
        const bf16* kn = kb + (size_t)(MP + b * DT) * D + col; const bf16* vn = vb + (size_t)(MP + b * DT) * D + col;
        if (g == 0) {
            const float* ck = cks + (size_t)(b * 8 + h) * SKV;
            float m = -1e30f, lsum = 0.f;
#define FOX_UPD(x, VAXPY) do { const float mn = fmaxf(m, (x)), al = exp2f(m - mn), p = exp2f((x) - mn); lsum = lsum * al + p; m = mn; \
    _Pragma("unroll") for (int d = 0; d < 32; ++d) o[d] *= al; VAXPY; } while (0)
            for (int s = 0; s < PAST; ++s) {
                float x = dot_row_f32<32>(ck_c + (size_t)s * W, q); x += __shfl_xor(x, 1); x += ck[s];
                FOX_UPD(x, axpy_row_f32<32>(cv_c + (size_t)s * W, rbf(p), o));
            }
            for (int j = 0; j < DT; ++j) {
                float x = dot_row_bf16<32>(kn + (size_t)j * D, q); x += __shfl_xor(x, 1); x += ck[PAST + j];
                if (j <= t) FOX_UPD(x, axpy_row_bf16<32>(vn + (size_t)j * D, rbf(p), o));
            }
#undef FOX_UPD
            const float inv = 1.0f / lsum;
#pragma unroll
            for (int d = 0; d < 32; ++d) o[d] *= inv;
        } else {
            float R = 0.f;
            for (int j = DT - 1; j >= 0; --j) {
                float z2 = dot_row_bf16<32>(kn + (size_t)j * D, q); z2 += __shfl_xor(z2, 1);
                if (j < t) { const float L2 = sb_logsig_neg2(z2), A = exp2f(z2 + L2 + R); axpy_row_bf16<32>(vn + (size_t)j * D, rbf(A), o); R += rhalf(L2); }
            }
            for (int s = PAST - 1; s >= 0; --s) {
                float z2 = dot_row_f32<32>(ck_c + (size_t)s * W, q); z2 += __shfl_xor(z2, 1);
                const float L2 = sb_logsig_neg2(z2), A = exp2f(z2 + L2 + R);
                axpy_row_f32<32>(cv_c + (size_t)s * W, rbf(A), o); R += rhalf(L2);
            }
        }
        float ssq = gate_store<32>(a, l, g, h * HD + hf * 32, row, o); ssq += __shfl_xor(ssq, 1);
        if (hf == 0) ((float*)(a.ws + WS_SSQ))[(size_t)row * 16 + g * 8 + h] = ssq;
    }
}

namespace att {
typedef short bf16x8 __attribute__((ext_vector_type(8)));
typedef _Float16 f16x8 __attribute__((ext_vector_type(8)));
typedef _Float16 f16x2 __attribute__((ext_vector_type(2)));
typedef float f32x16 __attribute__((ext_vector_type(16)));
typedef float f32x2 __attribute__((ext_vector_type(2)));
typedef __bf16 bf16x2_t __attribute__((ext_vector_type(2)));
typedef short s16x4 __attribute__((ext_vector_type(4)));
typedef LAS const char* lds_cptr;
constexpr float NEG = -1.0e30f;
constexpr float R_DONE = -151.0f;
constexpr int NSLOT = 4, A_K = 0, A_V = 32768, A_CK = 65536, A_WSF = 73728, A_FLAG = 75776, A_STG = 0;
constexpr int S_WSF = 132096, S_XT = 134144, S_ML = 136192, A_UNIT = 138240;

__device__ __forceinline__ int crow(int r, int hi) { return (r & 3) + 8 * (r >> 2) + 4 * hi; }
__device__ __forceinline__ void glds16(const void* gsrc, unsigned lds_dst) { unsigned keep;
    asm volatile("s_mov_b32 %0, m0\n\ts_mov_b32 m0, %2\n\ts_nop 0\n\tglobal_load_lds_dwordx4 %1, off\n\ts_mov_b32 m0, %0" : "=&s"(keep) : "v"(gsrc), "s"(lds_dst) : "memory"); }
__device__ __forceinline__ unsigned cvtpk(float lo, float hi) { f32x2 v = {lo, hi}; bf16x2_t b = __builtin_convertvector(v, bf16x2_t); return __builtin_bit_cast(unsigned, b); }
__device__ __forceinline__ unsigned cvtpk_h(float lo, float hi) { f32x2 v = {lo, hi}; f16x2 b = __builtin_convertvector(v, f16x2); return __builtin_bit_cast(unsigned, b); }
__device__ __forceinline__ float swap_max(float m) { auto rr = __builtin_amdgcn_permlane32_swap(__float_as_uint(m), __float_as_uint(m), false, false); return fmaxf(__uint_as_float(rr[0]), __uint_as_float(rr[1])); }
__device__ __forceinline__ float swap_sum(float m) { auto rr = __builtin_amdgcn_permlane32_swap(__float_as_uint(m), __float_as_uint(m), false, false); return __uint_as_float(rr[0]) + __uint_as_float(rr[1]); }
__device__ __forceinline__ float max3f(float a, float b, float c) { return __builtin_fmaxf(__builtin_fmaxf(a, b), c); }
__device__ __forceinline__ float fadd_s(float a, float b) { float r = a + b; asm volatile("" : "+v"(r)); return r; }
#define ATT_WAIT_BAR() asm volatile("s_waitcnt vmcnt(0) lgkmcnt(0)\n\ts_barrier" ::: "memory")
#define ATT_WAIT_BAR_N(N) asm volatile("s_waitcnt vmcnt(" #N ") lgkmcnt(0)\n\ts_barrier" ::: "memory")
#define ATT_LDS_WAIT() asm volatile("s_waitcnt lgkmcnt(0)" ::: "memory")

__device__ __forceinline__ void kfrags(bf16x8 (&kf)[8], lds_cptr kslot, int r32, int hi) {
    lds_cptr kb = kslot + hi * 1024 + r32 * 16;
#pragma unroll
    for (int d0 = 0; d0 < 4; ++d0) { kf[2 * d0] = *(const LAS bf16x8*)(kb + d0 * 2048); kf[2 * d0 + 1] = *(const LAS bf16x8*)(kb + d0 * 2048 + 512); }
}
__device__ __forceinline__ s16x4 vtr(lds_cptr p) { return __builtin_bit_cast(s16x4, __builtin_amdgcn_ds_read_tr16_b64_v4i16((LAS s16x4*)p)); }
struct VFrags { s16x4 lo[8], hh[8]; };
__device__ __forceinline__ void vfrags(VFrags& v, lds_cptr vp) {
#pragma unroll
    for (int i = 0; i < 8; ++i) { v.lo[i] = vtr(vp + (i >> 2) * 4096 + (i & 3) * 1024); v.hh[i] = vtr(vp + (i >> 2) * 4096 + (i & 3) * 1024 + 512); }
}
__device__ __forceinline__ void pv(f32x16 (&o)[2], const VFrags& v, const u32x4& pw0, const u32x4& pw1, const u32x4& pw2, const u32x4& pw3) {
#define ATT_VF(k) (bf16x8){v.lo[k][0], v.lo[k][1], v.lo[k][2], v.lo[k][3], v.hh[k][0], v.hh[k][1], v.hh[k][2], v.hh[k][3]}
    o[0] = __builtin_amdgcn_mfma_f32_32x32x16_bf16(__builtin_bit_cast(bf16x8, pw0), ATT_VF(0), o[0], 0, 0, 0);
    o[1] = __builtin_amdgcn_mfma_f32_32x32x16_bf16(__builtin_bit_cast(bf16x8, pw0), ATT_VF(4), o[1], 0, 0, 0);
    o[0] = __builtin_amdgcn_mfma_f32_32x32x16_bf16(__builtin_bit_cast(bf16x8, pw1), ATT_VF(1), o[0], 0, 0, 0);
    o[1] = __builtin_amdgcn_mfma_f32_32x32x16_bf16(__builtin_bit_cast(bf16x8, pw1), ATT_VF(5), o[1], 0, 0, 0);
    o[0] = __builtin_amdgcn_mfma_f32_32x32x16_bf16(__builtin_bit_cast(bf16x8, pw2), ATT_VF(2), o[0], 0, 0, 0);
    o[1] = __builtin_amdgcn_mfma_f32_32x32x16_bf16(__builtin_bit_cast(bf16x8, pw2), ATT_VF(6), o[1], 0, 0, 0);
    o[0] = __builtin_amdgcn_mfma_f32_32x32x16_bf16(__builtin_bit_cast(bf16x8, pw3), ATT_VF(3), o[0], 0, 0, 0);
    o[1] = __builtin_amdgcn_mfma_f32_32x32x16_bf16(__builtin_bit_cast(bf16x8, pw3), ATT_VF(7), o[1], 0, 0, 0);
#undef ATT_VF
}
#define ATT_PACK4(P, B, F) (u32x4){F(P[B], P[B + 1]), F(P[B + 2], P[B + 3]), F(P[B + 4], P[B + 5]), F(P[B + 6], P[B + 7])}
__device__ __forceinline__ f32x4 ld4(const LAS float* p) { return *(const LAS f32x4*)p; }
__device__ __forceinline__ f32x4 ld4(const float* p) { return *(const f32x4*)p; }

constexpr float FOX_THR = 8.0f;
constexpr float FOX_BIG = 1048576.0f;
struct FoxState { float m, l; bf16x8 mq; f32x16 o[2]; };
__device__ __forceinline__ float bf_hi_part(float x) { return __uint_as_float(cvtpk(x, 0.f) << 16); }
__device__ __forceinline__ bf16x8 make_mq(float m, int hi) {
    const float h1 = bf_hi_part(m), r1 = m - h1, h2 = bf_hi_part(r1), r2 = r1 - h2;
    u32x4 w = {0x3F803F80u, cvtpk(1.0f, h1), cvtpk(h2, r2), 0u};
    if (hi) { w.x = 0u; w.y = 0u; w.z = 0u; }
    return __builtin_bit_cast(bf16x8, w);
}
template <int LEVEL = 9, class CP>
__device__ __forceinline__ void fox_tile(FoxState& st, lds_cptr kslot, lds_cptr vp, const bf16x8 (&qr)[4], CP ckt  , bool masked, bool first, int qlim, int r32, int hi, LAS float* wsf) {
    bf16x8 kf[8]; kfrags(kf, kslot, r32, hi);
    f32x16 p0, p1;
#pragma unroll
    for (int g = 0; g < 4; ++g) { const f32x4 c0 = ld4(ckt + 8 * g), c1 = ld4(ckt + 32 + 8 * g);
#pragma unroll
        for (int i = 0; i < 4; ++i) { p0[4 * g + i] = c0[i]; p1[4 * g + i] = c1[i]; } }
    u32x4 kn = {0u, 0xBF800000u, 0xBF80BF80u, 0u}; if (hi) { kn.y = 0u; kn.z = 0u; }
    const bf16x8 kneg = __builtin_bit_cast(bf16x8, kn);
    p0 = __builtin_amdgcn_mfma_f32_32x32x16_bf16(kneg, st.mq, p0, 0, 0, 0);
    p1 = __builtin_amdgcn_mfma_f32_32x32x16_bf16(kneg, st.mq, p1, 0, 0, 0);
#pragma unroll
    for (int d0 = 0; d0 < 4; ++d0) {
        p0 = __builtin_amdgcn_mfma_f32_32x32x16_bf16(kf[2 * d0], qr[d0], p0, 0, 0, 0);
        p1 = __builtin_amdgcn_mfma_f32_32x32x16_bf16(kf[2 * d0 + 1], qr[d0], p1, 0, 0, 0);
    }
    __builtin_amdgcn_sched_barrier(0);
    if (LEVEL == 2) { asm volatile("" :: "v"(p0), "v"(p1)); return; }
    if (masked) {
        asm volatile("; masked tile" ::: "memory");
#pragma unroll
        for (int r = 0; r < 16; ++r) { const int kv = crow(r, hi); if (kv >= qlim) p0[r] = NEG; if (kv + 32 >= qlim) p1[r] = NEG; }
    }
    float rm = max3f(p0[0], p1[0], p0[1]), rm2 = max3f(p1[1], p0[2], p1[2]);
#pragma unroll
    for (int r = 3; r < 15; r += 2) { rm = max3f(rm, p0[r], p1[r]); rm2 = max3f(rm2, p0[r + 1], p1[r + 1]); }
    rm = max3f(rm, p0[15], p1[15]); rm = swap_max(max3f(rm, rm2, rm2));
    if (first || __any(rm > FOX_THR)) {
        const float dl = first ? rm : fmaxf(rm, 0.f);
        st.m += dl; st.mq = make_mq(st.m, hi);
#pragma unroll
        for (int r = 0; r < 16; ++r) { p0[r] -= dl; p1[r] -= dl; }
        if (!first) {
            const float f = __builtin_amdgcn_exp2f(-dl);
            st.l *= f;
            if (hi == 0) wsf[r32] = f;
            ATT_LDS_WAIT();
#pragma unroll
            for (int g = 0; g < 4; ++g) { const f32x4 fv = *(const LAS f32x4*)(wsf + 8 * g + 4 * hi);
#pragma unroll
                for (int i = 0; i < 4; ++i) { st.o[0][4 * g + i] *= fv[i]; st.o[1][4 * g + i] *= fv[i]; } }
        }
    }
    __builtin_amdgcn_sched_barrier(0);
    VFrags vf; vfrags(vf, vp);
    float sacc = 0.f, sacc2 = 0.f;
#pragma unroll
    for (int r = 0; r < 16; ++r) { p0[r] = __builtin_amdgcn_exp2f(p0[r]); p1[r] = __builtin_amdgcn_exp2f(p1[r]); sacc = fadd_s(sacc, p0[r]); sacc2 = fadd_s(sacc2, p1[r]); }
    st.l = fadd_s(st.l, fadd_s(sacc, sacc2));
    const u32x4 pw0 = ATT_PACK4(p0, 0, cvtpk), pw1 = ATT_PACK4(p0, 8, cvtpk), pw2 = ATT_PACK4(p1, 0, cvtpk), pw3 = ATT_PACK4(p1, 8, cvtpk);
    __builtin_amdgcn_sched_barrier(0);
    if (LEVEL == 3) { asm volatile("" :: "v"(pw0), "v"(pw1), "v"(pw2), "v"(pw3), "v"(vf.lo[0]), "v"(vf.hh[7])); return; }
    pv(st.o, vf, pw0, pw1, pw2, pw3);
}

struct SbTile { f32x16 z0, z1; u32x4 lw0, lw1, lw2, lw3; };
template <bool NEED_SUM>
__device__ __forceinline__ void sb_part1(SbTile& t, float& tsum, lds_cptr kslot, const bf16x8 (&qr)[4], bool masked, int qlim, int r32, int hi) {
    bf16x8 kf[8]; kfrags(kf, kslot, r32, hi);
    t.z0 = (f32x16){}; t.z1 = (f32x16){};
#pragma unroll
    for (int d0 = 0; d0 < 4; ++d0) {
        t.z0 = __builtin_amdgcn_mfma_f32_32x32x16_bf16(kf[2 * d0], qr[d0], t.z0, 0, 0, 0);
        t.z1 = __builtin_amdgcn_mfma_f32_32x32x16_bf16(kf[2 * d0 + 1], qr[d0], t.z1, 0, 0, 0);
    }
    __builtin_amdgcn_sched_barrier(0);
    f32x16 l0, l1;
#pragma unroll
    for (int r = 0; r < 16; ++r) {
        const float a0 = t.z0[r], a1 = t.z1[r];
        l0[r] = fmaxf(a0, 0.f) + __builtin_amdgcn_logf(1.0f + __builtin_amdgcn_exp2f(-__builtin_fabsf(a0)));
        l1[r] = fmaxf(a1, 0.f) + __builtin_amdgcn_logf(1.0f + __builtin_amdgcn_exp2f(-__builtin_fabsf(a1)));
    }
    if (masked) {
        asm volatile("; masked tile" ::: "memory");
#pragma unroll
        for (int r = 0; r < 16; ++r) { const int kv = crow(r, hi); if (kv >= qlim) l0[r] = 0.f; if (kv + 32 >= qlim) l1[r] = 0.f; }
    }
    if (NEED_SUM) {
        float s = 0.f, s2 = 0.f;
#pragma unroll
        for (int r = 0; r < 16; ++r) { s = fadd_s(s, l0[r]); s2 = fadd_s(s2, l1[r]); }
        tsum = -swap_sum(fadd_s(s, s2));
    }
    t.lw0 = ATT_PACK4(l0, 0, cvtpk_h); t.lw1 = ATT_PACK4(l0, 8, cvtpk_h); t.lw2 = ATT_PACK4(l1, 0, cvtpk_h); t.lw3 = ATT_PACK4(l1, 8, cvtpk_h);
}
__device__ __forceinline__ float sb_part2(f32x16 (&o)[2], const SbTile& t, float R, lds_cptr vp, const f16x8& T00, const f16x8& T01, bool masked, int qlim, int r32, int hi) {
    VFrags vf; vfrags(vf, vp);
    f32x16 w0, w1;
#pragma unroll
    for (int r = 0; r < 16; ++r) { w0[r] = R; w1[r] = R; }
    const f16x8 ones = {(_Float16)-1.0f, (_Float16)-1.0f, (_Float16)-1.0f, (_Float16)-1.0f, (_Float16)-1.0f, (_Float16)-1.0f, (_Float16)-1.0f, (_Float16)-1.0f};
    w0 = __builtin_amdgcn_mfma_f32_32x32x16_f16(T00, __builtin_bit_cast(f16x8, t.lw0), w0, 0, 0, 0);
    w1 = __builtin_amdgcn_mfma_f32_32x32x16_f16(T00, __builtin_bit_cast(f16x8, t.lw2), w1, 0, 0, 0);
    w0 = __builtin_amdgcn_mfma_f32_32x32x16_f16(T01, __builtin_bit_cast(f16x8, t.lw1), w0, 0, 0, 0);
    w1 = __builtin_amdgcn_mfma_f32_32x32x16_f16(T01, __builtin_bit_cast(f16x8, t.lw3), w1, 0, 0, 0);
    w0 = __builtin_amdgcn_mfma_f32_32x32x16_f16(ones, __builtin_bit_cast(f16x8, t.lw2), w0, 0, 0, 0);
    w0 = __builtin_amdgcn_mfma_f32_32x32x16_f16(ones, __builtin_bit_cast(f16x8, t.lw3), w0, 0, 0, 0);
    __builtin_amdgcn_sched_barrier(0);
    const float rnext = __shfl(w0[0], r32);
    f32x16 a0, a1;
#pragma unroll
    for (int r = 0; r < 16; ++r) { a0[r] = __builtin_amdgcn_exp2f(t.z0[r] + w0[r]); a1[r] = __builtin_amdgcn_exp2f(t.z1[r] + w1[r]); }
    if (masked) {
        asm volatile("; masked tile" ::: "memory");
#pragma unroll
        for (int r = 0; r < 16; ++r) { const int kv = crow(r, hi); if (kv >= qlim) a0[r] = 0.f; if (kv + 32 >= qlim) a1[r] = 0.f; }
    }
    const u32x4 pw0 = ATT_PACK4(a0, 0, cvtpk), pw1 = ATT_PACK4(a0, 8, cvtpk), pw2 = ATT_PACK4(a1, 0, cvtpk), pw3 = ATT_PACK4(a1, 8, cvtpk);
    __builtin_amdgcn_sched_barrier(0);
    pv(o, vf, pw0, pw1, pw2, pw3);
    return rnext;
}
__device__ __forceinline__ void make_tri(f16x8& T00, f16x8& T01, int r32, int hi) {
#pragma unroll
    for (int j = 0; j < 8; ++j) { const int kin = 8 * (j >> 2) + 4 * hi + (j & 3);
        T00[j] = (kin >= r32) ? (_Float16)-1.0f : (_Float16)0.0f; T01[j] = (16 + kin >= r32) ? (_Float16)-1.0f : (_Float16)0.0f; }
}

__device__ __forceinline__ float gate8(const f32x4& x0, const f32x4& x1, const float (&gn)[8], const u32x4& zw, bf16* orow) {
    const float zz[8] = {bflo(zw.x), bfhi(zw.x), bflo(zw.y), bfhi(zw.y), bflo(zw.z), bfhi(zw.z), bflo(zw.w), bfhi(zw.w)};
    const float xs[8] = {x0[0], x0[1], x0[2], x0[3], x1[0], x1[1], x1[2], x1[3]};
    float r[8], ssq = 0.f;
#pragma unroll
    for (int i = 0; i < 8; ++i) { ssq += xs[i] * xs[i]; r[i] = xs[i] * gn[i] * (zz[i] / (1.0f + __expf(-zz[i]))); }
    u32x4 w; w.x = cvtpk(r[0], r[1]); w.y = cvtpk(r[2], r[3]); w.z = cvtpk(r[4], r[5]); w.w = cvtpk(r[6], r[7]);
    *(u32x4*)orow = w;
    return ssq;
}

struct EpiPre { u32x4 z[4]; f32x4 g0, g1; };
template <int TYPE>
__device__ __forceinline__ void epi_preload(EpiPre& e, const Args& a, int l, int h, size_t rowq, int col, int lane) {
    const int ch = lane & 7;
    const float* gp = (TYPE == 0 ? a.gn_a : a.gn_b) + (size_t)l * W + h * HD + ch * 8;
    e.g0 = *(const f32x4*)gp; e.g1 = *(const f32x4*)(gp + 4);
#pragma unroll
    for (int i = 0; i < 4; ++i) e.z[i] = *(const u32x4*)((const bf16*)(a.ws + WS_Z) + (rowq + i * 8 + (lane >> 3)) * D + col + ch * 8);
}
template <int TYPE>
__device__ __forceinline__ void prompt_epilogue(const Args& a, int l, int h, size_t rowq  , int col, FoxState& st, const EpiPre& pre, LAS float* wsf, LAS float* stg, int lane, int r32, int hi) {
    if (TYPE == 0) {
        const float inv = 1.0f / swap_sum(st.l);
        if (hi == 0) wsf[r32] = inv;
        ATT_LDS_WAIT();
#pragma unroll
        for (int g = 0; g < 4; ++g) { const f32x4 f = *(const LAS f32x4*)(wsf + 8 * g + 4 * hi);
#pragma unroll
            for (int i = 0; i < 4; ++i) { st.o[0][4 * g + i] *= f[i]; st.o[1][4 * g + i] *= f[i]; } }
    }
#pragma unroll
    for (int r = 0; r < 16; ++r) { stg[crow(r, hi) * 64 + r32] = st.o[0][r]; stg[crow(r, hi) * 64 + 32 + r32] = st.o[1][r]; }
    ATT_LDS_WAIT();
    const int ch = lane & 7;
    const float gn[8] = {pre.g0[0], pre.g0[1], pre.g0[2], pre.g0[3], pre.g1[0], pre.g1[1], pre.g1[2], pre.g1[3]};
#pragma unroll
    for (int i = 0; i < 4; ++i) {
        const int row = i * 8 + (lane >> 3); const size_t grow = rowq + row;
        const f32x4 x0 = *(const LAS f32x4*)(stg + row * 64 + ch * 8), x1 = *(const LAS f32x4*)(stg + row * 64 + ch * 8 + 4);
        float ssq = gate8(x0, x1, gn, pre.z[i], (bf16*)(a.ws + WS_HN) + grow * D + col + ch * 8);
        ssq = sum8_dpp(ssq);
        if (ch == 0) ((float*)(a.ws + WS_SSQ))[grow * 16 + TYPE * 8 + h] = ssq;
    }
}

struct ConvRegs { u32x4 k[4], v[4]; };
__device__ __forceinline__ void conv_load(ConvRegs& c, const Args& a, size_t rowq, int col, int lane) {
#pragma unroll
    for (int i = 0; i < 4; ++i) { const size_t grow = rowq + i * 8 + (lane >> 3);
        c.k[i] = *(const u32x4*)((const bf16*)(a.ws + WS_K) + grow * D + col + (lane & 7) * 8); c.v[i] = *(const u32x4*)((const bf16*)(a.ws + WS_V) + grow * D + col + (lane & 7) * 8); }
}
template <int TYPE>
__device__ __forceinline__ void conv_store(const ConvRegs& c, const Args& a, int l, int h, size_t rowq, int lane) {
#pragma unroll
    for (int i = 0; i < 4; ++i) { const size_t grow = rowq + i * 8 + (lane >> 3);
        float* ko = a.out + (TYPE == 0 ? O_FKP : O_SKP) + ((size_t)l * MP + grow) * W + h * HD + (lane & 7) * 8;
        float* vo = a.out + (TYPE == 0 ? O_FVP : O_SVP) + ((size_t)l * MP + grow) * W + h * HD + (lane & 7) * 8;
        const u32x4 kw = c.k[i], vw = c.v[i];
        __builtin_nontemporal_store((f32x4){bflo(kw.x), bfhi(kw.x), bflo(kw.y), bfhi(kw.y)}, (f32x4*)ko); __builtin_nontemporal_store((f32x4){bflo(kw.z), bfhi(kw.z), bflo(kw.w), bfhi(kw.w)}, (f32x4*)(ko + 4));
        __builtin_nontemporal_store((f32x4){bflo(vw.x), bfhi(vw.x), bflo(vw.y), bfhi(vw.y)}, (f32x4*)vo); __builtin_nontemporal_store((f32x4){bflo(vw.z), bfhi(vw.z), bflo(vw.w), bfhi(vw.w)}, (f32x4*)(vo + 4)); }
}

struct PairP { u32x4 w[8]; };
__device__ __forceinline__ bool fox_pair_qs(FoxState& st, PairP& pp, lds_cptr kslotB, const bf16x8 (&qr)[4], const LAS u32x2* augB  , bool careful, int r32, int hi, LAS float* wsf) {
    bf16x8 kfA[8], kfB[8]; kfrags(kfA, kslotB + 8192, r32, hi); kfrags(kfB, kslotB, r32, hi);
    const u32x2 t0 = augB[64], t1 = augB[96], t2 = augB[0], t3 = augB[32];
    const f32x16 zz = {};
    f32x16 a0, a1, b0, b1;
    a0 = __builtin_amdgcn_mfma_f32_32x32x16_bf16(__builtin_bit_cast(bf16x8, (u32x4){t0.x, t0.y, 0xBF80BF80u, 0u}), st.mq, zz, 0, 0, 0);
    a1 = __builtin_amdgcn_mfma_f32_32x32x16_bf16(__builtin_bit_cast(bf16x8, (u32x4){t1.x, t1.y, 0xBF80BF80u, 0u}), st.mq, zz, 0, 0, 0);
    b0 = __builtin_amdgcn_mfma_f32_32x32x16_bf16(__builtin_bit_cast(bf16x8, (u32x4){t2.x, t2.y, 0xBF80BF80u, 0u}), st.mq, zz, 0, 0, 0);
    b1 = __builtin_amdgcn_mfma_f32_32x32x16_bf16(__builtin_bit_cast(bf16x8, (u32x4){t3.x, t3.y, 0xBF80BF80u, 0u}), st.mq, zz, 0, 0, 0);
#pragma unroll
    for (int d0 = 0; d0 < 4; ++d0) {
        a0 = __builtin_amdgcn_mfma_f32_32x32x16_bf16(kfA[2 * d0], qr[d0], a0, 0, 0, 0); a1 = __builtin_amdgcn_mfma_f32_32x32x16_bf16(kfA[2 * d0 + 1], qr[d0], a1, 0, 0, 0);
        b0 = __builtin_amdgcn_mfma_f32_32x32x16_bf16(kfB[2 * d0], qr[d0], b0, 0, 0, 0); b1 = __builtin_amdgcn_mfma_f32_32x32x16_bf16(kfB[2 * d0 + 1], qr[d0], b1, 0, 0, 0);
    }
    if (careful) {
        asm volatile("; careful pass: move the reference" ::: "memory");
        float rm = max3f(a0[0], a1[0], b0[0]), rm2 = max3f(b1[0], a0[1], a1[1]);
        rm = max3f(rm, b0[1], b1[1]);
#pragma unroll
        for (int r = 2; r < 16; ++r) { rm = max3f(rm, a0[r], a1[r]); rm2 = max3f(rm2, b0[r], b1[r]); }
        rm = swap_max(max3f(rm, rm2, rm2));
        const float dl = fmaxf(rm, 0.f);
        st.m += dl; st.mq = make_mq(st.m, hi);
#pragma unroll
        for (int r = 0; r < 16; ++r) { a0[r] -= dl; a1[r] -= dl; b0[r] -= dl; b1[r] -= dl; }
        const float f = __builtin_amdgcn_exp2f(-dl);
        st.l *= f;
        if (hi == 0) wsf[r32] = f;
        ATT_LDS_WAIT();
#pragma unroll
        for (int g = 0; g < 4; ++g) { const f32x4 fv = *(const LAS f32x4*)(wsf + 8 * g + 4 * hi);
#pragma unroll
            for (int i = 0; i < 4; ++i) { st.o[0][4 * g + i] *= fv[i]; st.o[1][4 * g + i] *= fv[i]; } }
    }
    float sacc = 0.f, sacc2 = 0.f;
#pragma unroll
    for (int r = 0; r < 16; ++r) { a0[r] = __builtin_amdgcn_exp2f(a0[r]); a1[r] = __builtin_amdgcn_exp2f(a1[r]); sacc = fadd_s(sacc, a0[r]); sacc2 = fadd_s(sacc2, a1[r]); }
    pp.w[0] = ATT_PACK4(a0, 0, cvtpk); pp.w[1] = ATT_PACK4(a0, 8, cvtpk); pp.w[2] = ATT_PACK4(a1, 0, cvtpk); pp.w[3] = ATT_PACK4(a1, 8, cvtpk);
#pragma unroll
    for (int r = 0; r < 16; ++r) { b0[r] = __builtin_amdgcn_exp2f(b0[r]); b1[r] = __builtin_amdgcn_exp2f(b1[r]); sacc = fadd_s(sacc, b0[r]); sacc2 = fadd_s(sacc2, b1[r]); }
    pp.w[4] = ATT_PACK4(b0, 0, cvtpk); pp.w[5] = ATT_PACK4(b0, 8, cvtpk); pp.w[6] = ATT_PACK4(b1, 0, cvtpk); pp.w[7] = ATT_PACK4(b1, 8, cvtpk);
    const float ts = fadd_s(sacc, sacc2);
    if (!careful && __any(!(ts < FOX_BIG))) return false;
    st.l = fadd_s(st.l, ts);
    return true;
}
__device__ __forceinline__ void fox_pair_pv(FoxState& st, const PairP& pp, lds_cptr vpB) {
    { VFrags vf; vfrags(vf, vpB + 8192); pv(st.o, vf, pp.w[0], pp.w[1], pp.w[2], pp.w[3]); }
    { VFrags vf; vfrags(vf, vpB); pv(st.o, vf, pp.w[4], pp.w[5], pp.w[6], pp.w[7]); }
}

constexpr int F_K = 0, F_V = 49152, F_CK = 98304, F_WSF = 106496, F_AUG = 108544;
__device__ __forceinline__ void prompt_unit_fox(const Args& a, int l, int b, int h, int qb, LAS unsigned char* lds) {
    int tid_ = threadIdx.x; asm volatile("" : "+v"(tid_));
    const int tid = tid_, lane = tid & 63, r32 = lane & 31, hi = lane >> 5, wid = __builtin_amdgcn_readfirstlane(tid >> 6);
    const int q0 = qb * 256, NP = (q0 + 256) / 128, jd = q0 / 64 + (wid >> 1), jpd = jd >> 1;
    const bool lateB = wid >= 4;
    const int col = h * HD;
    const size_t rowb = (size_t)b * T;
    const bf16* Kh = (const bf16*)(a.ws + WS_K) + rowb * D + col; const bf16* Vh = (const bf16*)(a.ws + WS_V) + rowb * D + col;
    const unsigned lds0 = (unsigned)(uintptr_t)lds;
    const bf16* ksrc = Kh + (size_t)lane * D + wid * 8;
    const bf16* vsrc = Vh + (size_t)(16 * (wid & 3) + (lane >> 2)) * D + (wid >> 2) * 32 + (lane & 3) * 8;
#define ATT_DMA2(jp, slot) do { \
        glds16(ksrc + (size_t)(jp) * 128 * D, (unsigned)__builtin_amdgcn_readfirstlane(lds0 + F_K + (slot) * 16384 + wid * 1024)); \
        glds16(ksrc + (size_t)(jp) * 128 * D + 64 * D, (unsigned)__builtin_amdgcn_readfirstlane(lds0 + F_K + (slot) * 16384 + 8192 + wid * 1024)); \
        glds16(vsrc + (size_t)(jp) * 128 * D, (unsigned)__builtin_amdgcn_readfirstlane(lds0 + F_V + (slot) * 16384 + wid * 1024)); \
        glds16(vsrc + (size_t)(jp) * 128 * D + 64 * D, (unsigned)__builtin_amdgcn_readfirstlane(lds0 + F_V + (slot) * 16384 + 8192 + wid * 1024)); } while (0)
    ATT_DMA2(NP - 1, 0);
    { const int idx = tid * 4; if (idx < q0 + 256) { const f32x4 c = *(const f32x4*)((const float*)(a.ws + WS_CKP) + (size_t)(b * 8 + h) * T + idx); *(LAS f32x4*)(lds + F_CK + idx * 4) = c;
#pragma unroll
        for (int e = 0; e < 4; ++e) { const float h1 = bf_hi_part(c[e]), r1 = c[e] - h1, h2 = bf_hi_part(r1), r2 = r1 - h2; ((LAS u32x2*)(lds + F_AUG))[idx + e] = (u32x2){cvtpk(h1, h2), cvtpk(r2, -1.0f)}; } } }
    bf16x8 qr[4];
    { const bf16* Qw = (const bf16*)(a.ws + WS_Q) + (rowb + q0 + wid * 32 + r32) * D + col;
#pragma unroll
      for (int d0 = 0; d0 < 4; ++d0) qr[d0] = *(const bf16x8*)(Qw + d0 * 16 + hi * 8); }
    const lds_cptr vp0 = (lds_cptr)lds + F_V + ((lane >> 4) & 1) * 32 + (lane & 3) * 8 + (4 * hi + ((lane & 15) >> 2)) * 64;
    const int ql = 32 * (wid & 1) + r32, qlim = ql + 1;
    LAS float* wsf = (LAS float*)(lds + F_WSF) + wid * 64;
    FoxState st; st.m = 0.f; st.l = 0.f; st.mq = (bf16x8){}; st.o[0] = (f32x16){}; st.o[1] = (f32x16){};
    PairP pp; bool pending = false;
#pragma unroll
    for (int i = 0; i < 8; ++i) pp.w[i] = (u32x4){0u, 0u, 0u, 0u};
    { ConvRegs cv; conv_load(cv, a, rowb + q0 + wid * 32, col, lane); conv_store<0>(cv, a, l, h, rowb + q0 + wid * 32, lane); }
    int slot = 0, pslot = 0;
    for (int jp = NP - 1; jp >= 0; --jp) {
        ATT_WAIT_BAR();
        if (jp >= 1) ATT_DMA2(jp - 1, slot == 2 ? 0 : slot + 1);
        const lds_cptr kslot = (lds_cptr)lds + F_K + slot * 16384; const lds_cptr vp = vp0 + slot * 16384;
        const LAS float* ck0 = (const LAS float*)(lds + F_CK) + (2 * jp) * 64 + 4 * hi;
        if (pending) { fox_pair_pv(st, pp, vp0 + pslot * 16384); pending = false; }
        if (jp < jpd) {
            bool careful = false;
#pragma unroll 1
            for (int pass = 0; pass < 2; ++pass) { if (fox_pair_qs(st, pp, kslot, qr, (const LAS u32x2*)(lds + F_AUG) + (2 * jp) * 64 + r32, careful, r32, hi, wsf)) break; careful = true; }
            if (lateB) { pending = true; pslot = slot; } else fox_pair_pv(st, pp, vp);
        } else if (jp == jpd) {
            if (jd & 1) { fox_tile(st, kslot + 8192, vp + 8192, qr, ck0 + 64, true, true, qlim, r32, hi, wsf); fox_tile(st, kslot, vp, qr, ck0, false, false, qlim, r32, hi, wsf); }
            else fox_tile(st, kslot, vp, qr, ck0, true, true, qlim, r32, hi, wsf);
        }
        slot = (slot == 2) ? 0 : slot + 1;
    }
#undef ATT_DMA2
    if (pending) fox_pair_pv(st, pp, vp0 + pslot * 16384);
    EpiPre pre; epi_preload<0>(pre, a, l, h, rowb + q0 + wid * 32, col, lane);
    ATT_WAIT_BAR();
    prompt_epilogue<0>(a, l, h, rowb + q0 + wid * 32, col, st, pre, wsf, (LAS float*)lds + wid * 2048, lane, r32, hi);
}

template <int TYPE, int SKEL = 0>
__device__ __forceinline__ void prompt_unit(const Args& a, int l, int b, int h, int qb, LAS unsigned char* lds) {
    int tid_ = threadIdx.x; asm volatile("" : "+v"(tid_));
    const int tid = tid_, lane = tid & 63, r32 = lane & 31, hi = lane >> 5, wid = __builtin_amdgcn_readfirstlane(tid >> 6);
    f16x8 T00, T01; if (TYPE == 1) make_tri(T00, T01, r32, hi);
    const int q0 = qb * 256, NT = (q0 + 256) / 64, jd = q0 / 64 + (wid >> 1);
    const int col = TYPE * W + h * HD;
    const size_t rowb = (size_t)b * T;
    const bf16* Kh = (const bf16*)(a.ws + WS_K) + rowb * D + col; const bf16* Vh = (const bf16*)(a.ws + WS_V) + rowb * D + col;
    const unsigned lds0 = (unsigned)(uintptr_t)lds;
    const bf16* ksrc = Kh + (size_t)lane * D + wid * 8;
    const bf16* vsrc = Vh + (size_t)(16 * (wid & 3) + (lane >> 2)) * D + (wid >> 2) * 32 + (lane & 3) * 8;
#define ATT_DMA(jt, slot) do { glds16(ksrc + (size_t)(jt) * 64 * D, (unsigned)__builtin_amdgcn_readfirstlane(lds0 + A_K + (slot) * 8192 + wid * 1024)); \
                               glds16(vsrc + (size_t)(jt) * 64 * D, (unsigned)__builtin_amdgcn_readfirstlane(lds0 + A_V + (slot) * 8192 + wid * 1024)); } while (0)
    ATT_DMA(NT - 1, 0); ATT_DMA(NT - 2, 1); ATT_DMA(NT - 3, 2);
    if (TYPE == 0) { const int idx = tid * 4; if (idx < q0 + 256) *(LAS f32x4*)(lds + A_CK + idx * 4) = *(const f32x4*)((const float*)(a.ws + WS_CKP) + (size_t)(b * 8 + h) * T + idx); }
    bf16x8 qr[4];
    { const bf16* Qw = (const bf16*)(a.ws + WS_Q) + (rowb + q0 + wid * 32 + r32) * D + col;
#pragma unroll
      for (int d0 = 0; d0 < 4; ++d0) qr[d0] = *(const bf16x8*)(Qw + d0 * 16 + hi * 8); }
    const lds_cptr vp0 = (lds_cptr)lds + A_V + ((lane >> 4) & 1) * 32 + (lane & 3) * 8 + (4 * hi + ((lane & 15) >> 2)) * 64;
    const int ql = 32 * (wid & 1) + r32, qlim = (TYPE == 0) ? ql + 1 : ql;
    LAS float* wsf = (LAS float*)(lds + A_WSF) + wid * 64;
    LAS unsigned* flags = (LAS unsigned*)(lds + A_FLAG);
    FoxState st; st.m = 0.f; st.l = 0.f; st.mq = (bf16x8){}; st.o[0] = (f32x16){}; st.o[1] = (f32x16){};
    float R = 0.f; bool done = false;
    { ConvRegs cv; conv_load(cv, a, rowb + q0 + wid * 32, col, lane); conv_store<TYPE>(cv, a, l, h, rowb + q0 + wid * 32, lane); }
    int it = 0;
    for (int jt = NT - 1; jt >= 0; --jt, ++it) {
        if (jt >= 2) ATT_WAIT_BAR_N(4); else if (jt == 1) ATT_WAIT_BAR_N(2); else ATT_WAIT_BAR_N(0);
        if (TYPE == 1 && it > 0) {
            const u32x4 f0 = *(const LAS u32x4*)(flags + ((it - 1) & 1) * 8), f1 = *(const LAS u32x4*)(flags + ((it - 1) & 1) * 8 + 4);
            if ((f0.x & f0.y & f0.z & f0.w & f1.x & f1.y & f1.z & f1.w) != 0u) break;
        }
        if (jt >= 3) ATT_DMA(jt - 3, (it + 3) & 3);
        const int slot = it & 3;
        const lds_cptr kslot = (lds_cptr)lds + A_K + slot * 8192; const lds_cptr vp = vp0 + slot * 8192;
        if (SKEL != 1 && jt <= jd && !done) {
            if (TYPE == 0) {
                const LAS float* ckt = (const LAS float*)(lds + A_CK) + jt * 64 + 4 * hi;
                fox_tile<SKEL == 0 ? 9 : SKEL>(st, kslot, vp, qr, ckt, jt == jd, jt == jd, qlim, r32, hi, wsf);
            } else {
                SbTile tl; float tsum;
                sb_part1<false>(tl, tsum, kslot, qr, jt == jd, qlim, r32, hi); R = sb_part2(st.o, tl, R, vp, T00, T01, jt == jd, qlim, r32, hi);
                done = __all(R < R_DONE);
            }
        }
        if (TYPE == 1 && lane == 0) flags[(it & 1) * 8 + wid] = done ? 1u : 0u;
    }
#undef ATT_DMA
    EpiPre pre; epi_preload<TYPE>(pre, a, l, h, rowb + q0 + wid * 32, col, lane);
    ATT_WAIT_BAR();
    if (SKEL) { asm volatile("" :: "v"(st.o[0]), "v"(st.o[1]), "v"(st.l)); return; }
    prompt_epilogue<TYPE>(a, l, h, rowb + q0 + wid * 32, col, st, pre, wsf, (LAS float*)(lds + A_STG) + wid * 2048, lane, r32, hi);
}

constexpr int B_K = 0, B_V = 65536, B_WSF = 132096, B_FLAG = 134144, B_STG = 0;
__device__ __forceinline__ void prompt_unit_sb(const Args& a, int l, int b, int h, int qb, LAS unsigned char* lds) {
    int tid_ = threadIdx.x; asm volatile("" : "+v"(tid_));
    const int tid = tid_, lane = tid & 63, r32 = lane & 31, hi = lane >> 5, wid = __builtin_amdgcn_readfirstlane(tid >> 6);
    f16x8 T00, T01; make_tri(T00, T01, r32, hi);
    const int q0 = qb * 256, jb = q0 / 64, jd = jb + (wid >> 1);
    const int col = W + h * HD;
    const size_t rowb = (size_t)b * T;
    const bf16* Kh = (const bf16*)(a.ws + WS_K) + rowb * D + col; const bf16* Vh = (const bf16*)(a.ws + WS_V) + rowb * D + col;
    const unsigned lds0 = (unsigned)(uintptr_t)lds;
    const bf16* ksrc = Kh + (size_t)lane * D + wid * 8;
    const bf16* vsrc = Vh + (size_t)(16 * (wid & 3) + (lane >> 2)) * D + (wid >> 2) * 32 + (lane & 3) * 8;
#define ATT_DMA(jt) do { const int s_ = (jt) & 7; glds16(ksrc + (size_t)(jt) * 64 * D, (unsigned)__builtin_amdgcn_readfirstlane(lds0 + B_K + s_ * 8192 + wid * 1024)); \
                         glds16(vsrc + (size_t)(jt) * 64 * D, (unsigned)__builtin_amdgcn_readfirstlane(lds0 + B_V + s_ * 8192 + wid * 1024)); } while (0)
    ATT_DMA(jb + 3); ATT_DMA(jb + 2); ATT_DMA(jb + 1); ATT_DMA(jb);
    if (jb >= 4) { ATT_DMA(jb - 1); ATT_DMA(jb - 2); ATT_DMA(jb - 3); }
    bf16x8 qr[4];
    { const bf16* Qw = (const bf16*)(a.ws + WS_Q) + (rowb + q0 + wid * 32 + r32) * D + col;
#pragma unroll
      for (int d0 = 0; d0 < 4; ++d0) qr[d0] = *(const bf16x8*)(Qw + d0 * 16 + hi * 8); }
    const lds_cptr vp0 = (lds_cptr)lds + B_V + ((lane >> 4) & 1) * 32 + (lane & 3) * 8 + (4 * hi + ((lane & 15) >> 2)) * 64;
    const int qlim = 32 * (wid & 1) + r32;
    LAS float* wsf = (LAS float*)(lds + B_WSF) + wid * 64;
    LAS unsigned* flags = (LAS unsigned*)(lds + B_FLAG);
    FoxState st; st.m = 0.f; st.l = 0.f; st.mq = (bf16x8){}; st.o[0] = (f32x16){}; st.o[1] = (f32x16){};
    float R = 0.f; bool done = false;
    {
        ConvRegs cv; conv_load(cv, a, rowb + q0 + wid * 32, col, lane);
        if (jb >= 3) ATT_WAIT_BAR_N(6); else ATT_WAIT_BAR_N(0);
        if (jb >= 4) ATT_DMA(jb - 4);
        conv_store<1>(cv, a, l, h, rowb + q0 + wid * 32, lane);
        { const int slot = jd & 7;
          const lds_cptr kslot = (lds_cptr)lds + B_K + slot * 8192; const lds_cptr vp = vp0 + slot * 8192;
          SbTile tl; float tsum;
          sb_part1<false>(tl, tsum, kslot, qr, true, qlim, r32, hi); R = sb_part2(st.o, tl, R, vp, T00, T01, true, qlim, r32, hi);
          done = __all(R < R_DONE); }
        if (jd <= 0) done = true;
        if (lane == 0) flags[wid] = done ? 1u : 0u;
    }
    for (int it = 1; ; ++it) {
        const int need = jb - it;
        if (need >= 3) ATT_WAIT_BAR_N(6); else if (need == 2) ATT_WAIT_BAR_N(4); else if (need == 1) ATT_WAIT_BAR_N(2); else ATT_WAIT_BAR_N(0);
        {
            const u32x4 f0 = *(const LAS u32x4*)(flags + ((it - 1) & 1) * 8), f1 = *(const LAS u32x4*)(flags + ((it - 1) & 1) * 8 + 4);
            if ((f0.x & f0.y & f0.z & f0.w & f1.x & f1.y & f1.z & f1.w) != 0u) break;
        }
        if (need >= 4) ATT_DMA(need - 4);
        const int jt = jd - it;
        if (jt >= 0 && !done) {
            const int slot = jt & 7;
            const lds_cptr kslot = (lds_cptr)lds + B_K + slot * 8192; const lds_cptr vp = vp0 + slot * 8192;
            SbTile tl; float tsum;
            sb_part1<false>(tl, tsum, kslot, qr, false, qlim, r32, hi); R = sb_part2(st.o, tl, R, vp, T00, T01, false, qlim, r32, hi);
            done = __all(R < R_DONE);
        }
        if (jt <= 0) done = true;
        if (lane == 0) flags[(it & 1) * 8 + wid] = done ? 1u : 0u;
    }
#undef ATT_DMA
    EpiPre pre; epi_preload<1>(pre, a, l, h, rowb + q0 + wid * 32, col, lane);
    ATT_WAIT_BAR();
    prompt_epilogue<1>(a, l, h, rowb + q0 + wid * 32, col, st, pre, wsf, (LAS float*)(lds + B_STG) + wid * 2048, lane, r32, hi);
}

template <int TYPE>
__device__ __forceinline__ void sample_unit(const Args& a, int l, int b, int h, LAS unsigned char* lds) {
    int tid_ = threadIdx.x; asm volatile("" : "+v"(tid_));
    const int tid = tid_, lane = tid & 63, r32 = lane & 31, hi = lane >> 5, wid = __builtin_amdgcn_readfirstlane(tid >> 6);
    f16x8 T00, T01; if (TYPE == 1) make_tri(T00, T01, r32, hi);
    const int col = TYPE * W + h * HD;
    LAS unsigned char* kreg = lds + wid * 16384; LAS unsigned char* vreg = kreg + 8192;
    const float* kc = (TYPE == 0 ? a.c_fk : a.c_sk) + (((size_t)l * DB + b) * PAST) * W + h * HD;
    const float* vc = (TYPE == 0 ? a.c_fv : a.c_sv) + (((size_t)l * DB + b) * PAST) * W + h * HD;
    const float* kn = a.out + (TYPE == 0 ? O_FKS : O_SKS) + ((size_t)l * MS + b * DT) * W + h * HD;
    const float* vn = a.out + (TYPE == 0 ? O_FVS : O_SVS) + ((size_t)l * MS + b * DT) * W + h * HD;
    const float* ckb = (const float*)(a.ws + WS_CKS) + (size_t)(b * 8 + h) * SKV;
    bf16x8 qr[4];
    { const bf16* Qw = (const bf16*)(a.ws + WS_Q) + ((size_t)MP + b * DT + (r32 & 15)) * D + col;
#pragma unroll
      for (int d0 = 0; d0 < 4; ++d0) { qr[d0] = *(const bf16x8*)(Qw + d0 * 16 + hi * 8); if (r32 >= 16) qr[d0] = (bf16x8){}; } }
    const lds_cptr vp = (lds_cptr)vreg + ((lane >> 4) & 1) * 32 + (lane & 3) * 8 + (4 * hi + ((lane & 15) >> 2)) * 64;
    const int qlim_new = (TYPE == 0) ? (r32 < 16 ? r32 + 1 : 16) : (r32 < 16 ? r32 : 0);
    LAS float* wsf = (LAS float*)(lds + S_WSF) + wid * 64;
    LAS float* xT = (LAS float*)(lds + S_XT);
    FoxState st; st.m = 0.f; st.l = 0.f; st.mq = (bf16x8){}; st.o[0] = (f32x16){}; st.o[1] = (f32x16){};
    float Rround = 0.f; bool started = false;
#define ATT_STAGE(src, nrows, ISV) do { _Pragma("unroll") for (int hh_ = 0; hh_ < 2; ++hh_) { f32x4 t_[8]; \
        _Pragma("unroll") for (int i = 0; i < 8; ++i) { const int row = 32 * hh_ + 4 * i + (lane >> 4); t_[i] = (row < (nrows)) ? __builtin_nontemporal_load((const f32x4*)((src) + (size_t)row * W + 4 * (lane & 15))) : (f32x4){0.f, 0.f, 0.f, 0.f}; }   \
        _Pragma("unroll") for (int i = 0; i < 8; ++i) { const int row = 32 * hh_ + 4 * i + (lane >> 4), c4 = lane & 15; u32x2 w_; w_.x = cvtpk(t_[i][0], t_[i][1]); w_.y = cvtpk(t_[i][2], t_[i][3]); \
            if (ISV) *(LAS u32x2*)(vreg + (c4 >> 3) * 4096 + (row >> 4) * 1024 + (row & 15) * 64 + (c4 & 7) * 8) = w_; \
            else *(LAS u32x2*)(kreg + (c4 >> 1) * 1024 + row * 16 + (c4 & 1) * 8) = w_; } asm volatile("" ::: "memory"); } } while (0)
    for (int rnd = 0; rnd < 9; ++rnd) {
        const int gidx = rnd * 8 + 7 - wid; const bool valid = gidx <= 64, isnew = gidx == 0; const int ct = 64 - gidx;
        const float* ksrc = isnew ? kn : kc + (size_t)ct * 64 * W; const float* vsrc = isnew ? vn : vc + (size_t)ct * 64 * W;
        const int nrows = isnew ? DT : 64;
        if (TYPE == 0) {
            if (valid) {
                ATT_LDS_WAIT();
                ATT_STAGE(ksrc, nrows, false); ATT_STAGE(vsrc, nrows, true);
                ATT_LDS_WAIT();
                const float* ckt = ckb + (isnew ? PAST : ct * 64) + 4 * hi;
                fox_tile(st, (lds_cptr)kreg, vp, qr, ckt, isnew, !started, qlim_new, r32, hi, wsf);
                started = true;
            }
        } else {
            SbTile tl; float tsum = 0.f;
            if (valid) {
                ATT_LDS_WAIT();
                ATT_STAGE(ksrc, nrows, false); ATT_STAGE(vsrc, nrows, true);
                ATT_LDS_WAIT();
                sb_part1<true>(tl, tsum, (lds_cptr)kreg, qr, isnew, qlim_new, r32, hi);
            }
            if (hi == 0) xT[((rnd & 1) * 8 + wid) * 32 + r32] = tsum;
            ATT_WAIT_BAR();
            float Rin = Rround, Rall = Rround;
#pragma unroll
            for (int w2 = 7; w2 >= 0; --w2) { const float tv = xT[((rnd & 1) * 8 + w2) * 32 + r32]; if (w2 > wid) Rin += tv; Rall += tv; }
            if (valid) (void)sb_part2(st.o, tl, Rin, vp, T00, T01, isnew, qlim_new, r32, hi);
            Rround = Rall;
            if (__all(r32 >= 16 || Rround < R_DONE)) break;
        }
    }
#undef ATT_STAGE
    LAS float* ml = (LAS float*)(lds + S_ML);
    if (TYPE == 0) {
        const float lt = swap_sum(st.l);
        if (!started) st.m = NEG;
        if (hi == 0) { ml[(wid * 2 + 0) * 32 + r32] = st.m; ml[(wid * 2 + 1) * 32 + r32] = lt; }
        ATT_WAIT_BAR();
        float M = NEG;
#pragma unroll
        for (int w2 = 0; w2 < 8; ++w2) M = fmaxf(M, ml[(w2 * 2) * 32 + r32]);
        float Lt = 0.f;
#pragma unroll
        for (int w2 = 0; w2 < 8; ++w2) Lt += __builtin_amdgcn_exp2f(ml[(w2 * 2) * 32 + r32] - M) * ml[(w2 * 2 + 1) * 32 + r32];
        const float sc = __builtin_amdgcn_exp2f(st.m - M) / Lt;
        if (hi == 0) wsf[r32] = sc;
        ATT_LDS_WAIT();
#pragma unroll
        for (int g = 0; g < 4; ++g) { const f32x4 f = *(const LAS f32x4*)(wsf + 8 * g + 4 * hi);
#pragma unroll
            for (int i = 0; i < 4; ++i) { st.o[0][4 * g + i] *= f[i]; st.o[1][4 * g + i] *= f[i]; } }
    }
    LAS float* stg = (LAS float*)kreg;
    ATT_LDS_WAIT();
#pragma unroll
    for (int r = 0; r < 16; ++r) { stg[crow(r, hi) * 64 + r32] = st.o[0][r]; stg[crow(r, hi) * 64 + 32 + r32] = st.o[1][r]; }
    ATT_WAIT_BAR();
    {
        const int row = 2 * wid + hi, c2 = 2 * r32;
        float s0 = 0.f, s1 = 0.f;
#pragma unroll
        for (int w2 = 0; w2 < 8; ++w2) { const f32x2 v = *(const LAS f32x2*)(lds + w2 * 16384 + (row * 64 + c2) * 4); s0 += v[0]; s1 += v[1]; }
        const size_t grow = (size_t)MP + b * DT + row;
        const unsigned zw = *(const unsigned*)((const bf16*)(a.ws + WS_Z) + grow * D + col + c2);
        const float* gp = (TYPE == 0 ? a.gn_a : a.gn_b) + (size_t)l * W + h * HD + c2;
        const float z0 = bflo(zw), z1 = bfhi(zw);
        const float g0 = s0 * gp[0] * (z0 / (1.0f + __expf(-z0))), g1 = s1 * gp[1] * (z1 / (1.0f + __expf(-z1)));
        *(unsigned*)((bf16*)(a.ws + WS_HN) + grow * D + col + c2) = cvtpk(g0, g1);
        float ssq = s0 * s0 + s1 * s1;
#pragma unroll
        for (int o2 = 1; o2 < 32; o2 <<= 1) ssq += __shfl_xor(ssq, o2);
        if (r32 == 0) ((float*)(a.ws + WS_SSQ))[grow * 16 + TYPE * 8 + h] = ssq;
    }
}

__device__ __forceinline__ int next_unit(unsigned* ctr, LAS unsigned char* lds) {
    ATT_WAIT_BAR();
    if (threadIdx.x == 0) *(LAS unsigned*)(lds + A_UNIT) = __hip_atomic_fetch_add(ctr, 1u, __ATOMIC_RELAXED, __HIP_MEMORY_SCOPE_AGENT);
    ATT_WAIT_BAR();
    return (int)*(volatile LAS unsigned*)(lds + A_UNIT);
}
#define ATT_QUEUE(CTR, LIMIT, CALL) do { int u = next_unit((CTR), lds); int par_ = 0; \
        while (u < (LIMIT)) { unsigned nxt_ = 0u; if (threadIdx.x == 0) nxt_ = __hip_atomic_fetch_add((CTR), 1u, __ATOMIC_RELAXED, __HIP_MEMORY_SCOPE_AGENT); \
            CALL; \
            if (threadIdx.x == 0) *(LAS unsigned*)(lds + A_UNIT + 16 + 4 * par_) = nxt_; \
            ATT_WAIT_BAR();                                    \
            u = (int)*(volatile LAS unsigned*)(lds + A_UNIT + 16 + 4 * par_); par_ ^= 1; } } while (0)
__device__ __forceinline__ void phase_attention(const Args& a, int l, LAS unsigned char* lds, unsigned* qctr  ) {
    constexpr int NS = 2 * DB * H, NPU = 2 * NB * H * 8, EVERY = 15, MIXED = NS * (EVERY + 1);
    ATT_QUEUE(qctr, NS + NPU, {
        const int us = __builtin_amdgcn_readfirstlane(u);
        int sidx = -1; int pidx;
        if (us < MIXED) { const int blkq = us / (EVERY + 1); const int r = us - blkq * (EVERY + 1); if (r == 0) sidx = blkq; pidx = blkq * EVERY + r - 1; }
        else pidx = NS * EVERY + (us - MIXED);
        if (sidx >= 0) { if (sidx < DB * H) sample_unit<0>(a, l, sidx >> 3, sidx & 7, lds); else { const int v = sidx - DB * H; sample_unit<1>(a, l, v >> 3, v & 7, lds); } }
        else if (pidx < NB * H * 8) prompt_unit_fox(a, l, pidx >> 6, (pidx >> 3) & 7, 7 - (pidx & 7), lds);
        else { const int v = pidx - NB * H * 8; prompt_unit_sb(a, l, (v & 255) >> 3, v & 7, 7 - (v >> 8), lds); }
    });
}
}

__device__ __forceinline__ void phase_final(const Args& a, int gwave, int nwaves, int lane) {
    const bf16* xb = (const bf16*)(a.ws + WS_XP);
    f32x4 gg[4];
#pragma unroll
    for (int j = 0; j < 4; ++j) gg[j] = *(const f32x4*)(a.fin_g + 4 * lane + 256 * j);
    for (int pr = gwave; pr < MT / 2; pr += nwaves) {
        const int r0 = 2 * pr, r1 = r0 + 1;
        u32x2 a_[4], b_[4];
#pragma unroll
        for (int j = 0; j < 4; ++j) { a_[j] = *(const u32x2*)(xb + (size_t)r0 * D + 4 * lane + 256 * j); b_[j] = *(const u32x2*)(xb + (size_t)r1 * D + 4 * lane + 256 * j); }
        f32x4 v[4], w[4]; float sa = 0.f, sb = 0.f;
#pragma unroll
        for (int j = 0; j < 4; ++j) { v[j] = (f32x4){bflo(a_[j].x), bfhi(a_[j].x), bflo(a_[j].y), bfhi(a_[j].y)}; w[j] = (f32x4){bflo(b_[j].x), bfhi(b_[j].x), bflo(b_[j].y), bfhi(b_[j].y)};
            sa += (v[j].x * v[j].x + v[j].y * v[j].y) + (v[j].z * v[j].z + v[j].w * v[j].w); sb += (w[j].x * w[j].x + w[j].y * w[j].y) + (w[j].z * w[j].z + w[j].w * w[j].w); }
        sa = wave_sum(sa); sb = wave_sum(sb);
        const float ra = 1.0f / sqrtf(sa * (1.0f / D) + EPS), rb = 1.0f / sqrtf(sb * (1.0f / D) + EPS);
        float* d0 = (r0 < MP) ? a.out + O_YP + (size_t)r0 * D : a.out + O_YS + (size_t)(r0 - MP) * D;
        float* d1 = (r1 < MP) ? a.out + O_YP + (size_t)r1 * D : a.out + O_YS + (size_t)(r1 - MP) * D;
#pragma unroll
        for (int j = 0; j < 4; ++j) { __builtin_nontemporal_store(v[j] * ra * gg[j], (f32x4*)(d0 + 4 * lane + 256 * j)); __builtin_nontemporal_store(w[j] * rb * gg[j], (f32x4*)(d1 + 4 * lane + 256 * j)); }
    }
}

#define IN(k) (lo <= (k) && (k) < hi)
#define SEAM(k) do { if (IN(k) && IN((k) + 1)) xcd_barrier(bar); } while (0)
typedef const __attribute__((address_space(4))) Args* KArgs;
__device__ __forceinline__ Args load_args(KArgs k) { Args a; a.x_prompt = k->x_prompt; a.x_sample = k->x_sample; a.c_fk = k->c_fk; a.c_fv = k->c_fv; a.c_fl = k->c_fl; a.c_sk = k->c_sk; a.c_sv = k->c_sv;
    a.norm_g = k->norm_g; a.w_in = k->w_in; a.b_f = k->b_f; a.gn_a = k->gn_a; a.gn_b = k->gn_b; a.w_out = k->w_out; a.fin_g = k->fin_g; a.out = k->out; a.ws = k->ws; a.ph_lo = k->ph_lo; a.ph_hi = k->ph_hi; return a; }
#define FRESH_IDS() KArgs kp_ = kp0; asm volatile("" : "+s"(kp_)); const Args a = load_args(kp_); int tid = threadIdx.x; asm volatile("" : "+v"(tid)); const int lane = tid & 63, wave = __builtin_amdgcn_readfirstlane(tid >> 6); \
    const int G = gridDim.x, blk = blockIdx.x; const int gtid = blk * NTHR + tid, gthreads = G * NTHR, gwave = blk * 8 + wave, nwaves = G * 8; \
    (void)lane; (void)gtid; (void)gthreads; (void)gwave; (void)nwaves
template <int l> __device__ __forceinline__ void run_layer(KArgs kp0, LAS unsigned char* lds, const XcdBarrier& bar, int lo, int hi) {
    constexpr int pb = 1 + 4 * l;
        if (IN(pb)) { FRESH_IDS(); if (l == 0) { phase_prep(a, gtid, gthreads, lds, wave, gwave, nwaves, lane); phase_norm(a, 0, gwave, nwaves, lane); } else phase_stats1(a, gwave, nwaves, lane); }
        SEAM(pb);
        if (IN(pb + 1)) {
            FRESH_IDS();
            phase_cumsum(a, l, lds, blk, wave, lane);
            EpiIn E{l, (bf16*)(a.ws + WS_Q), (bf16*)(a.ws + WS_K), (bf16*)(a.ws + WS_V), (bf16*)(a.ws + WS_Z), a.out};
#if FAST_GEMM
            { EpiInS ES{l, (bf16*)(a.ws + WS_Q), (bf16*)(a.ws + WS_K), (bf16*)(a.ws + WS_V), (bf16*)(a.ws + WS_Z), a.out, (l == 1) ? (const float*)(a.ws + WS_RSTD) : nullptr};
              for (int su = blk; su < 4 * (NPROJ / 64); su += G) small_gemm<false>((const bf16*)(a.ws + (l == 0 ? WS_HN : WS_XP)) + (size_t)MP * D, (const bf16*)(a.ws + WS_WIN) + (size_t)l * NPROJ * D, NPROJ, ES, su); }
            { pg8::Gemm gm{(const bf16*)(a.ws + (l == 0 ? WS_HN : WS_XP)), (const bf16*)(a.ws + WS_WIN) + (size_t)l * NPROJ * D, MP, NPROJ, D}; pg8::StaticOrder S; S.init(MP, NPROJ, G, blk);
              EpiInProj EF{l, (bf16*)(a.ws + WS_Q), (bf16*)(a.ws + WS_K), (bf16*)(a.ws + WS_V), (bf16*)(a.ws + WS_Z), nullptr  , (l == 1) ? (const float*)(a.ws + WS_RSTD) : nullptr};
              pg8::gemm_phase<EpiInProj, pg8::StaticOrder, true, true>(lds, gm, S, EF);
              if (PROBE_DOUBLE == 2) pg8::gemm_phase<EpiInProj, pg8::StaticOrder, true, true>(lds, gm, S, EF);
              if (PROBE_DOUBLE == 11) { EpiInProj EF2 = EF; EF2.out = nullptr; pg8::gemm_phase<EpiInProj, pg8::StaticOrder, true, true>(lds, gm, S, EF2); } }
#else
            naive_gemm<false>(lds, (const bf16*)(a.ws + WS_HN), (const bf16*)(a.ws + WS_WIN) + (size_t)l * NPROJ * D, MT, NPROJ, D, E, blk, G);
#endif
        }
        SEAM(pb + 1);
#if FAST_ATTN
        if (IN(pb + 2)) { FRESH_IDS(); att::phase_attention(a, l, lds, (unsigned*)(a.ws + WS_CTL) + CW_QUEUE + l * 256);
}
#else
        if (IN(pb + 2)) { FRESH_IDS(); attn_sample_naive(a, l, gtid, gthreads); attn_prompt_naive(a, l, gtid, gthreads); }
#endif
        SEAM(pb + 2);
        if (IN(pb + 3)) {
            FRESH_IDS();
            EpiOut E{l, a.x_prompt, a.x_sample, (const float*)(a.ws + WS_SSQ), (float*)(a.ws + WS_XP)};
#if FAST_GEMM
            { EpiOutS ES{l, a.x_sample, (const float*)(a.ws + WS_SSQ), (float*)(a.ws + WS_XP)};
              for (int su = blk; su < 4 * (D / 64); su += G) small_gemm<true>((const bf16*)(a.ws + WS_HN) + (size_t)MP * D, (const bf16*)(a.ws + WS_WOUT) + (size_t)l * D * D, D, ES, su); }
            { pg8::Gemm gm{(const bf16*)(a.ws + WS_HN), (const bf16*)(a.ws + WS_WOUT) + (size_t)l * D * D, MP, D, D}; pg8::StaticOrder S; S.init(MP, D, G, blk);
              EpiOutProj EF{l, a.x_prompt, a.x_sample, (const float*)(a.ws + WS_SSQ), (float*)(a.ws + WS_XP), (LAS float*)(lds + TAB_OFF)};
              pg8::gemm_phase<EpiOutProj, pg8::StaticOrder, true, true>(lds, gm, S, EF);
              if (PROBE_DOUBLE == 9 && l == 0) pg8::gemm_phase<EpiOutProj, pg8::StaticOrder, true, true>(lds, gm, S, EF); }
#else
            naive_gemm<true>(lds, (const bf16*)(a.ws + WS_HN), (const bf16*)(a.ws + WS_WOUT) + (size_t)l * D * D, MT, D, D, E, blk, G);
#endif
        }
        SEAM(pb + 3);
    }
#undef IN
#undef SEAM

constexpr int N_PHASES = 10;
__global__ void __launch_bounds__(NTHR, 2) fwd(Args a_in) {
    extern __shared__ __attribute__((aligned(16))) unsigned char lds_raw[];
    LAS unsigned char* lds = (LAS unsigned char*)lds_raw;
    volatile LAS unsigned* MISC = (volatile LAS unsigned*)(lds + MISC_OFF);
    if (threadIdx.x < 32) MISC[threadIdx.x] = 0u;
    __syncthreads();
    const KArgs kp0 = (KArgs)__builtin_amdgcn_kernarg_segment_ptr();
    unsigned* ctl = (unsigned*)(a_in.ws + WS_CTL);
    const bool multi = (a_in.ph_hi - a_in.ph_lo) > 1;
    XcdBarrier bar; bar.bar = ctl + CW_BAR; bar.x = 0; bar.st = nullptr;
    if (multi) bar = xcd_barrier_post(ctl + CW_BAR, MISC + 8);
    const int lo = a_in.ph_lo, hi = a_in.ph_hi;
#define IN(k) (lo <= (k) && (k) < hi)
#define SEAM(k) do { if (IN(k) && IN((k) + 1)) xcd_barrier(bar); } while (0)
    run_layer<0>(kp0, lds, bar, lo, hi);
    run_layer<1>(kp0, lds, bar, lo, hi);
    if (IN(9)) { FRESH_IDS(); phase_final(a, gwave, nwaves, lane); if (PROBE_DOUBLE == 10) phase_final(a, gwave, nwaves, lane); }
#undef IN
#undef SEAM
}

#ifndef MK_ONE_LAUNCH
#define MK_ONE_LAUNCH 1
#endif
extern "C" void kernel_launch(void* const* d_in, const int* in_sizes, int n_in, void* d_out, int out_size, void* d_ws, size_t ws_size, hipStream_t stream) {
    static int grid = 0;
    if (grid == 0) {
        if (n_in != 14 || (size_t)out_size != O_END || ws_size < WS_END) { fprintf(stderr, "kernel_launch: unexpected shapes: n_in %d out %d (want %zu) ws %zu (want %zu)\n", n_in, out_size, (size_t)O_END, ws_size, (size_t)WS_END); grid = -1; return; }
        int dev = 0, cus = 0, per_cu = 0;
        if (hipGetDevice(&dev) != hipSuccess || hipDeviceGetAttribute(&cus, hipDeviceAttributeMultiprocessorCount, dev) != hipSuccess) { grid = -1; return; }
        if (hipFuncSetAttribute((const void*)fwd, hipFuncAttributeMaxDynamicSharedMemorySize, LDS_BYTES) != hipSuccess) { fprintf(stderr, "kernel_launch: hipFuncSetAttribute failed\n"); grid = -1; return; }
        if (hipOccupancyMaxActiveBlocksPerMultiprocessor(&per_cu, (const void*)fwd, NTHR, LDS_BYTES) != hipSuccess || per_cu < 1) fprintf(stderr, "kernel_launch: occupancy query says %d\n", per_cu);
        (void)hipGetLastError();
        grid = cus;
    }
    if (grid < 0) return;
    (void)hipMemsetAsync((char*)d_ws + WS_CTL, 0, CTL_ZERO_BYTES, stream);
    Args a{};
    a.x_prompt = (const float*)d_in[0]; a.x_sample = (const float*)d_in[1]; a.c_fk = (const float*)d_in[2]; a.c_fv = (const float*)d_in[3]; a.c_fl = (const float*)d_in[4];
    a.c_sk = (const float*)d_in[5]; a.c_sv = (const float*)d_in[6]; a.norm_g = (const float*)d_in[7]; a.w_in = (const float*)d_in[8]; a.b_f = (const float*)d_in[9];
    a.gn_a = (const float*)d_in[10]; a.gn_b = (const float*)d_in[11]; a.w_out = (const float*)d_in[12]; a.fin_g = (const float*)d_in[13];
    a.out = (float*)d_out; a.ws = (unsigned char*)d_ws;
#if MK_ONE_LAUNCH
    a.ph_lo = 0; a.ph_hi = N_PHASES;
    hipLaunchKernelGGL(fwd, dim3(grid), dim3(NTHR), LDS_BYTES, stream, a);
#else
    for (int p = 0; p < N_PHASES; ++p) { a.ph_lo = p; a.ph_hi = p + 1; hipLaunchKernelGGL(fwd, dim3(grid), dim3(NTHR), LDS_BYTES, stream, a); }
#endif
}
```

```cpp
#include <hip/hip_runtime.h>
#include <cstdio>
#include <cstdint>

constexpr int D = 1024, NB = 32, T = 2048, MP = NB * T;
constexpr int DB = 16, DT = 16, MS = DB * DT, MT = MP + MS;
constexpr int PAST = 4096, SKV = PAST + DT;
constexpr int H = 8, HD = 64, W = 512, IN_DIM = 4104, NPROJ = 4096;
constexpr float EPS = 1e-6f;
constexpr float LOG2E = 1.4426950408889634f;
constexpr float C2 = 0.125f * LOG2E;

constexpr size_t O_YP = 0, O_YS = O_YP + (size_t)MP * D, O_FKP = O_YS + (size_t)MS * D, O_FVP = O_FKP + 2ull * MP * W, O_FLP = O_FVP + 2ull * MP * W,
                 O_SKP = O_FLP + 2ull * MP * H, O_SVP = O_SKP + 2ull * MP * W, O_FKS = O_SVP + 2ull * MP * W, O_FVS = O_FKS + 2ull * MS * W,
                 O_FLS = O_FVS + 2ull * MS * W, O_SKS = O_FLS + 2ull * MS * H, O_SVS = O_SKS + 2ull * MS * W, O_END = O_SVS + 2ull * MS * W;

constexpr size_t MiB = 1u << 20;
constexpr size_t WS_CTL = 0, CTL_ZERO_BYTES = 64 * 1024;
constexpr size_t WS_WIN = 1 * MiB;
constexpr size_t WS_WOUT = 17 * MiB;
constexpr size_t WS_WF = 21 * MiB;
constexpr size_t WS_CKP = 22 * MiB;
constexpr size_t WS_CKS = 24 * MiB;
constexpr size_t WS_SSQ = 27 * MiB;
constexpr size_t WS_HN = 32 * MiB;
constexpr size_t WS_Q = 161 * MiB, WS_K = 290 * MiB, WS_V = 419 * MiB, WS_Z = 548 * MiB;
constexpr size_t WS_XP = 677 * MiB;
constexpr size_t WS_RSTD = 21 * MiB + 512 * 1024;
constexpr size_t WS_END = 935 * MiB;
static_assert((size_t)MT * D * 2 <= 129 * MiB && (size_t)MT * D * 4 <= 258 * MiB, "ws map");
constexpr int CW_BAR = 4096;
constexpr int CW_QUEUE = 8192;

typedef unsigned short bf16;
typedef float f32x4 __attribute__((ext_vector_type(4)));
typedef unsigned u32x4 __attribute__((ext_vector_type(4)));
typedef unsigned u32x2 __attribute__((ext_vector_type(2)));
#define LAS __attribute__((address_space(3)))

__device__ __forceinline__ bf16 f2bf(float f) { unsigned u = __float_as_uint(f); u += 0x7fffu + ((u >> 16) & 1u); return (bf16)(u >> 16); }
__device__ __forceinline__ float bf2f(bf16 h) { return __uint_as_float((unsigned)h << 16); }
__device__ __forceinline__ unsigned pk2(float lo, float hi) { return (unsigned)f2bf(lo) | ((unsigned)f2bf(hi) << 16); }
__device__ __forceinline__ float bflo(unsigned w) { return __uint_as_float(w << 16); }
__device__ __forceinline__ float bfhi(unsigned w) { return __uint_as_float(w & 0xffff0000u); }
template <int CTRL> __device__ __forceinline__ float dpp_mov(float v) { return __int_as_float(__builtin_amdgcn_update_dpp(0, __float_as_int(v), CTRL, 0xF, 0xF, false)); }
__device__ __forceinline__ float sum8_dpp(float v) {
    v += dpp_mov<0xB1>(v);
    v += dpp_mov<0x4E>(v);
    v += dpp_mov<0x141>(v);
    return v;
}
__device__ __forceinline__ float wave_sum(float v) {
    v = sum8_dpp(v);
    v += dpp_mov<0x140>(v);
    return __int_as_float(__builtin_amdgcn_readlane(__float_as_int(v), 0)) + __int_as_float(__builtin_amdgcn_readlane(__float_as_int(v), 16))
         + __int_as_float(__builtin_amdgcn_readlane(__float_as_int(v), 32)) + __int_as_float(__builtin_amdgcn_readlane(__float_as_int(v), 48));
}
__device__ __forceinline__ float gate_reduce(const f32x4& f0, const f32x4& f1, int lane) {
    const bool h4 = lane & 16, h3 = lane & 8;
    f32x4 k4;
#pragma unroll
    for (int i = 0; i < 4; ++i) { auto rr = __builtin_amdgcn_permlane32_swap(__float_as_uint(f0[i]), __float_as_uint(f1[i]), false, false); k4[i] = __uint_as_float(rr[0]) + __uint_as_float(rr[1]); }
    float k2a, k2b; { const float m0 = h4 ? k4[2] : k4[0], m1 = h4 ? k4[3] : k4[1], g0 = h4 ? k4[0] : k4[2], g1 = h4 ? k4[1] : k4[3];
        k2a = m0 + __shfl_xor(g0, 16); k2b = m1 + __shfl_xor(g1, 16); }
    const float m0 = h3 ? k2b : k2a, g0 = h3 ? k2a : k2b;
    return sum8_dpp(m0 + dpp_mov<0x140>(g0));
}

#define XB_TMO      128
#define XB_XCNT(j)  (256  + 64 * (j))
#define XB_XSUB(j)  (1280 + 64 * (j))
#define XB_XGEN(j)  (2304 + 64 * (j))
#define XB_TOP      3328
#define XB_TOPGEN   3392
#define XCD_BAR_WORDS 3456
#define XB_SPIN_CAP (1u << 24)
__device__ __forceinline__ unsigned xb_ld(unsigned* p)              { return __hip_atomic_load(p, __ATOMIC_RELAXED, __HIP_MEMORY_SCOPE_AGENT); }
__device__ __forceinline__ unsigned xb_add(unsigned* p, unsigned v) { return __hip_atomic_fetch_add(p, v, __ATOMIC_RELAXED, __HIP_MEMORY_SCOPE_AGENT); }
__device__ __forceinline__ unsigned xb_xcc_id() { return (unsigned)__builtin_amdgcn_s_getreg((3 << 11) | 20) & 0xFu; }
#define XB_SPIN(cond, bar) do { unsigned _sp = 0; while (cond) { __builtin_amdgcn_s_sleep(1); \
    if ((++_sp & 255u) == 0u) { if (xb_ld(&(bar)[XB_TMO])) break; if (_sp > XB_SPIN_CAP) { atomicAdd(&(bar)[XB_TMO], 1u); break; } } } } while (0)
struct XcdBarrier { unsigned* bar; unsigned x; volatile LAS unsigned* st; };
__device__ __forceinline__ XcdBarrier xcd_barrier_post(unsigned* bar, volatile LAS unsigned* st) {
    XcdBarrier b; b.bar = bar; b.x = xb_xcc_id(); b.st = st;
    if (threadIdx.x == 0) (void)xb_add(&bar[XB_XCNT(b.x)], 1u);
    return b;
}
__device__ __forceinline__ void xcd_barrier_complete(unsigned* bar, unsigned x, unsigned& nloc, unsigned& nx) {
    const unsigned G = gridDim.x * gridDim.y * gridDim.z;
    unsigned sum, cnt, mine, sp = 0u;
    for (;;) {
        sum = 0u; cnt = 0u; mine = 0u;
#pragma unroll
        for (unsigned j = 0; j < 16; ++j) { const unsigned c = xb_ld(&bar[XB_XCNT(j)]); sum += c; cnt += (c > 0u) ? 1u : 0u; mine = (j == x) ? c : mine; }
        if (sum == G) break;
        __builtin_amdgcn_s_sleep(1);
        if ((++sp & 255u) == 0u) { if (xb_ld(&bar[XB_TMO])) break; if (sp > XB_SPIN_CAP) { atomicAdd(&bar[XB_TMO], 1u); break; } }
    }
    nloc = mine > 0u ? mine : 1u; nx = cnt > 0u ? cnt : 1u;
}
__device__ __forceinline__ void xcd_barrier(const XcdBarrier& b) {
    asm volatile("s_waitcnt vmcnt(0)" ::: "memory");
    __syncthreads();
    if (threadIdx.x == 0) {
        unsigned* bar = b.bar;
        __builtin_amdgcn_s_waitcnt(0);
        unsigned nloc = b.st[0], nx = b.st[1];
        if (nloc == 0u) { xcd_barrier_complete(bar, b.x, nloc, nx); b.st[0] = nloc; b.st[1] = nx; }
        const unsigned old = xb_add(&bar[XB_XSUB(b.x)], 1u);
        const unsigned gen = old / nloc;
        if (old + 1u == (gen + 1u) * nloc) {
            __builtin_amdgcn_fence(__ATOMIC_RELEASE, "agent");
            asm volatile("s_waitcnt vmcnt(0)" ::: "memory");
            const unsigned og = xb_add(&bar[XB_TOP], 1u);
            const unsigned tg = og / nx;
            if (og + 1u == (tg + 1u) * nx) xb_add(&bar[XB_TOPGEN], 1u);
            else XB_SPIN(xb_ld(&bar[XB_TOPGEN]) == tg, bar);
            __builtin_amdgcn_fence(__ATOMIC_ACQUIRE, "agent");
            xb_add(&bar[XB_XGEN(b.x)], 1u);
            asm volatile("s_waitcnt vmcnt(0)" ::: "memory");
        } else {
            XB_SPIN(xb_ld(&bar[XB_XGEN(b.x)]) == gen, bar);
            __builtin_amdgcn_fence(__ATOMIC_ACQUIRE, "agent");
            asm volatile("s_waitcnt vmcnt(0)" ::: "memory");
        }
    }
    __syncthreads();
}

namespace pg8 {
#define PG8_LAS __attribute__((address_space(3)))
typedef unsigned short bf16_t;
typedef short bf16x8 __attribute__((ext_vector_type(8)));
typedef float f32x4 __attribute__((ext_vector_type(4)));
typedef unsigned u32x4 __attribute__((ext_vector_type(4)));
constexpr int BM = 256, BK = 64, HALF = 128, HTB = HALF * BK * 2  , STAGE_BYTES = 8 * HTB, NXCD = 8, WGM = 8;

__host__ __device__ __forceinline__ int lds_byte(int r, int c) { const int st = (r >> 4) * 2 + (c >> 5), rr = r & 15, cc = c & 31, ob = rr * 64 + cc * 2; return st * 1024 + (ob ^ (((ob >> 9) & 1) << 5)); }
__host__ __device__ __forceinline__ void stage_rc(int b, int& R, int& C) { const int st = b / 1024, sb = b % 1024, swz = sb ^ (((sb >> 9) & 1) << 5); R = (st >> 1) * 16 + swz / 64; C = (st & 1) * 32 + (swz % 64) / 2; }
__host__ __device__ __forceinline__ int perm32(int rho) { const int n = rho >> 4, i = rho & 15; return 8 * (i >> 2) + 4 * n + (i & 3); }

struct Unit { int pm, pn; };
struct Gemm { const bf16_t* A; const bf16_t* Bt; int M, N, K; };

struct StaticOrder {
    int nM, nN, nwg, G, c;
    __host__ __device__ void init(int M, int N, int G_, int c_) { nM = M / BM; nN = N / BM; nwg = nM * nN; G = G_; c = c_; }
    __host__ __device__ bool next(int i, Unit& u) const {
        const long L = (long)i * G + c; if (L >= nwg) return false;
        int wgid = (int)L; { const int q = nwg / NXCD, r = nwg % NXCD, xcd = wgid % NXCD, off = wgid / NXCD; wgid = (xcd < r ? xcd * (q + 1) : r * (q + 1) + (xcd - r) * q) + off; }
        const int nig = WGM * nN, gid = wgid / nig, fm = gid * WGM, gsz = (nM - fm) < WGM ? (nM - fm) : WGM;
        u.pm = fm + ((wgid % nig) % gsz); u.pn = (wgid % nig) / gsz; return true;
    }
    __device__ __forceinline__ void a_ready(const Unit&) const {}
    __device__ __forceinline__ void done(const Unit&) const {}
};

__device__ __forceinline__ unsigned cvt_pk_bf16(float lo, float hi) { unsigned r; asm volatile("v_cvt_pk_bf16_f32 %0, %1, %2" : "=v"(r) : "v"(lo), "v"(hi)); return r; }
template <class Epi, class Sched, bool ALIGN_EPI = false, bool SP2 = false>
__device__ __forceinline__ void gemm_phase(PG8_LAS unsigned char* lds, const Gemm g, const Sched& S, const Epi& E) {
    int tid_ = threadIdx.x; asm volatile("" : "+v"(tid_));
    const int tid = tid_, wid = __builtin_amdgcn_readfirstlane(tid >> 6), lane = tid & 63, wr = wid >> 2, wc = wid & 3, fr = lane & 15, fq = lane >> 4;
    const int K = g.K, nt = K / BK;
    unsigned voffA[2], voffB[2];
#pragma unroll
    for (int i = 0; i < 2; ++i) { int R, C; stage_rc(tid * 16 + i * 8192, R, C); const int Rb = Epi::PERM ? ((R & ~31) + perm32(R & 31)) : R;
        voffA[i] = (unsigned)(R * K + C) * 2u; voffB[i] = (unsigned)(Rb * K + C) * 2u; }
    const size_t kstep = (size_t)(BK * 2);
    const size_t hstep = (size_t)HALF * K * 2;
    const size_t tstep = 2 * hstep;
    const unsigned ldsw = (unsigned)wid * 1024u;
    const int aoff = lds_byte(wr * 64 + fr, fq * 8), boff = lds_byte(wc * 32 + fr, fq * 8);
#define PG8_SA(b, h) (((b) * 2 + (h)) * HTB)
#define PG8_SB(b, h) ((4 + (b) * 2 + (h)) * HTB)
#define PG8_STAGE(bufoff, gbase, voff) do { _Pragma("unroll") for (int _i = 0; _i < 2; ++_i) \
        __builtin_amdgcn_global_load_lds((const unsigned*)((const char*)(gbase) + (voff)[_i]), (PG8_LAS unsigned*)(lds + (bufoff) + ldsw + _i * 8192), 16, 0, 0); } while (0)
#define PG8_LDA(dst, b, h) do { _Pragma("unroll") for (int m = 0; m < 4; ++m) _Pragma("unroll") for (int k = 0; k < 2; ++k) dst[m][k] = *(const PG8_LAS bf16x8*)(lds + PG8_SA(b, h) + aoff + m * 2048 + k * 1024); } while (0)
#define PG8_LDB(dst, b, h) do { _Pragma("unroll") for (int n = 0; n < 2; ++n) _Pragma("unroll") for (int k = 0; k < 2; ++k) dst[n][k] = *(const PG8_LAS bf16x8*)(lds + PG8_SB(b, h) + boff + n * 2048 + k * 1024); } while (0)
#define PG8_MMA(ai, bj, At, Bt) do { __builtin_amdgcn_s_setprio(1); _Pragma("unroll") for (int m = 0; m < 4; ++m) _Pragma("unroll") for (int n = 0; n < 2; ++n) _Pragma("unroll") for (int k = 0; k < 2; ++k) \
        acc[ai][bj][m][n] = __builtin_amdgcn_mfma_f32_16x16x32_bf16(Bt[n][k], At[m][k], acc[ai][bj][m][n], 0, 0, 0); __builtin_amdgcn_s_setprio(0); } while (0)
#define PG8_WAIT_V(n) asm volatile("s_waitcnt vmcnt(" #n ")" ::: "memory")
#define PG8_WAIT_L(n) asm volatile("s_waitcnt lgkmcnt(" #n ")" ::: "memory")
#define PG8_BAR __builtin_amdgcn_s_barrier()
#define PG8_SCHED __builtin_amdgcn_sched_barrier(0)
    Unit cur, nxt; int ui = 0;
    if (!S.next(0, cur)) return;
    f32x4 acc[2][2][4][2];
#pragma unroll
    for (int a = 0; a < 2; ++a)
#pragma unroll
        for (int b = 0; b < 2; ++b)
#pragma unroll
            for (int m = 0; m < 4; ++m)
#pragma unroll
                for (int n = 0; n < 2; ++n) acc[a][b][m][n] = (f32x4){0.f, 0.f, 0.f, 0.f};
    bf16x8 At[4][2], B0[2][2], B1[2][2];
    const char* cA = (const char*)g.A + (size_t)cur.pm * tstep; const char* cB = (const char*)g.Bt + (size_t)cur.pn * tstep;
    S.a_ready(cur);
    if constexpr (SP2) {
        PG8_STAGE(PG8_SB(0, 0), cB, voffB); PG8_STAGE(PG8_SB(0, 1), cB + hstep, voffB); PG8_STAGE(PG8_SA(0, 0), cA, voffA); PG8_STAGE(PG8_SA(0, 1), cA + hstep, voffA);
        if (wr == 1) PG8_BAR;
        PG8_WAIT_V(2); PG8_BAR;
        PG8_STAGE(PG8_SB(1, 0), cB + kstep, voffB); PG8_STAGE(PG8_SA(1, 0), cA + kstep, voffA); PG8_STAGE(PG8_SB(1, 1), cB + hstep + kstep, voffB);
        PG8_WAIT_V(6); PG8_BAR;
    } else {
        PG8_STAGE(PG8_SB(0, 0), cB, voffB); PG8_STAGE(PG8_SA(0, 0), cA, voffA); PG8_STAGE(PG8_SB(0, 1), cB + hstep, voffB); PG8_STAGE(PG8_SA(0, 1), cA + hstep, voffA);
        if (wr == 1) PG8_BAR;
        PG8_WAIT_V(4); PG8_BAR;
        PG8_STAGE(PG8_SB(1, 0), cB + kstep, voffB); PG8_STAGE(PG8_SA(1, 0), cA + kstep, voffA); PG8_STAGE(PG8_SB(1, 1), cB + hstep + kstep, voffB);
        PG8_WAIT_V(6); PG8_BAR;
    }
    for (;;) {
        E.begin(cur, ui);
        const bool has_next = S.next(ui + 1, nxt);
        const char* nA = has_next ? (const char*)g.A + (size_t)nxt.pm * tstep : cA; const char* nB = has_next ? (const char*)g.Bt + (size_t)nxt.pn * tstep : cB;
        for (int t = 0; t < nt; t += 2) {
            if constexpr (Epi::MIDSCALE) { if (t == 8) E.mid(acc, cur, ui, wr, fr); }
            const bool last = (t == nt - 2);
            const char* a1 = cA + (size_t)(t + 1) * kstep;
            const char* a2 = last ? nA : cA + (size_t)(t + 2) * kstep; const char* b2 = last ? nB : cB + (size_t)(t + 2) * kstep;
            const char* a3 = a2 + kstep; const char* b3 = b2 + kstep;
            if (last && has_next) S.a_ready(nxt);
            if constexpr (SP2) {
            PG8_LDB(B0, 0, 0); PG8_LDB(B1, 0, 1); PG8_SCHED; PG8_LDA(At, 0, 0); PG8_STAGE(PG8_SA(1, 1), a1 + hstep, voffA);
            PG8_WAIT_V(8); PG8_WAIT_L(0); PG8_BAR; PG8_MMA(0, 0, At, B0); PG8_MMA(0, 1, At, B1); PG8_BAR; PG8_SCHED;
            PG8_LDA(At, 0, 1); PG8_STAGE(PG8_SB(0, 0), b2, voffB); PG8_STAGE(PG8_SB(0, 1), b2 + hstep, voffB); PG8_STAGE(PG8_SA(0, 0), a2, voffA);
            PG8_WAIT_V(8); PG8_WAIT_L(0); PG8_BAR; PG8_MMA(1, 0, At, B0); PG8_MMA(1, 1, At, B1); PG8_BAR; PG8_SCHED;
            PG8_LDB(B0, 1, 0); PG8_LDB(B1, 1, 1); PG8_SCHED; PG8_LDA(At, 1, 0); PG8_STAGE(PG8_SA(0, 1), a2 + hstep, voffA);
            PG8_WAIT_V(8); PG8_WAIT_L(0); PG8_BAR; PG8_MMA(0, 0, At, B0); PG8_MMA(0, 1, At, B1); PG8_BAR; PG8_SCHED;
            PG8_LDA(At, 1, 1); PG8_STAGE(PG8_SB(1, 0), b3, voffB); PG8_STAGE(PG8_SB(1, 1), b3 + hstep, voffB); PG8_STAGE(PG8_SA(1, 0), a3, voffA);
            PG8_WAIT_V(8); PG8_WAIT_L(0); PG8_BAR; PG8_MMA(1, 0, At, B0); PG8_MMA(1, 1, At, B1); PG8_BAR; PG8_SCHED;
            } else {
            PG8_LDB(B0, 0, 0); PG8_SCHED; PG8_LDA(At, 0, 0); PG8_STAGE(PG8_SA(1, 1), a1 + hstep, voffA);
            PG8_WAIT_L(8); PG8_BAR; PG8_WAIT_L(0); PG8_MMA(0, 0, At, B0); PG8_BAR; PG8_SCHED;
            PG8_LDB(B1, 0, 1); PG8_STAGE(PG8_SB(0, 0), b2, voffB);
            PG8_BAR; PG8_WAIT_L(0); PG8_MMA(0, 1, At, B1); PG8_BAR;
            PG8_LDA(At, 0, 1); PG8_STAGE(PG8_SA(0, 0), a2, voffA);
            PG8_BAR; PG8_WAIT_L(0); PG8_MMA(1, 0, At, B0); PG8_BAR; PG8_SCHED;
            PG8_STAGE(PG8_SB(0, 1), b2 + hstep, voffB);
            PG8_WAIT_V(6); PG8_BAR; PG8_MMA(1, 1, At, B1); PG8_BAR;
            PG8_LDB(B0, 1, 0); PG8_SCHED; PG8_LDA(At, 1, 0); PG8_STAGE(PG8_SA(0, 1), a2 + hstep, voffA);
            PG8_WAIT_L(8); PG8_BAR; PG8_WAIT_L(0); PG8_MMA(0, 0, At, B0); PG8_BAR; PG8_SCHED;
            PG8_LDB(B1, 1, 1); PG8_STAGE(PG8_SB(1, 0), b3, voffB);
            PG8_BAR; PG8_WAIT_L(0); PG8_MMA(0, 1, At, B1); PG8_BAR;
            PG8_LDA(At, 1, 1); PG8_STAGE(PG8_SA(1, 0), a3, voffA);
            PG8_BAR; PG8_WAIT_L(0); PG8_MMA(1, 0, At, B0); PG8_BAR; PG8_SCHED;
            PG8_STAGE(PG8_SB(1, 1), b3 + hstep, voffB);
            PG8_WAIT_V(6); PG8_BAR; PG8_MMA(1, 1, At, B1); PG8_BAR;
            }
        }
        if constexpr (ALIGN_EPI) { if (wr == 0) PG8_BAR; }
        if constexpr (!Epi::AFTER_DRAIN) { E(acc, cur, ui, wr, wc, fr, fq); S.done(cur); }
        if (!has_next) break;
#pragma unroll
        for (int a = 0; a < 2; ++a)
#pragma unroll
            for (int b = 0; b < 2; ++b)
#pragma unroll
                for (int m = 0; m < 4; ++m)
#pragma unroll
                    for (int n = 0; n < 2; ++n) acc[a][b][m][n] = (f32x4){0.f, 0.f, 0.f, 0.f};
        cur = nxt; cA = nA; cB = nB; ++ui;
        if constexpr (ALIGN_EPI) { if (wr == 1) PG8_BAR; }
    }
    PG8_WAIT_V(0);
    if constexpr (!ALIGN_EPI) { if (wr == 0) PG8_BAR; }
    PG8_BAR;
    if constexpr (Epi::AFTER_DRAIN) { E.fused(acc, cur, wr, wc, fr, fq, lds, wid, lane); S.done(cur); }
#undef PG8_SA
#undef PG8_SB
#undef PG8_STAGE
#undef PG8_LDA
#undef PG8_LDB
#undef PG8_MMA
#undef PG8_WAIT_V
#undef PG8_WAIT_L
#undef PG8_BAR
#undef PG8_SCHED
}
}

struct Args {
    const float* x_prompt; const float* x_sample; const float* c_fk; const float* c_fv; const float* c_fl; const float* c_sk; const float* c_sv;
    const float* norm_g; const float* w_in; const float* b_f; const float* gn_a; const float* gn_b; const float* w_out; const float* fin_g;
    float* out; unsigned char* ws; int ph_lo, ph_hi;
};
constexpr int NTHR = 512;
constexpr int LDS_BYTES = 147456;
constexpr int MISC_OFF = 131072 + 320;
constexpr int TAB_OFF = 131072 + 1024;
#ifndef FAST_GEMM
#define FAST_GEMM 1
#endif
#ifndef FAST_ATTN
#define FAST_ATTN 1
#endif
#ifndef PROBE_LEVEL
#define PROBE_LEVEL 3
#endif
#ifndef PROBE_DOUBLE
#define PROBE_DOUBLE 0
#endif

__device__ __forceinline__ int src_col(int n) {
    const int j = n >> 9, c = n & 511;
    const int off = (j == 0) ? 0 : (j == 1) ? 2056 : (j == 2) ? 512 : (j == 3) ? 2568 : (j == 4) ? 1024 : (j == 5) ? 3080 : (j == 6) ? 1544 : 3592;
    return off + c;
}
__device__ __forceinline__ void phase_prep(const Args& a, int gtid, int gthreads, LAS unsigned char* lds, int wave, int gwave, int nwaves, int lane) {
    bf16* win = (bf16*)(a.ws + WS_WIN); bf16* wout = (bf16*)(a.ws + WS_WOUT); float* wf = (float*)(a.ws + WS_WF);
    LAS float* tile = (LAS float*)(lds + wave * 8448);
    const int rn = lane & 31, rk = lane >> 5, wn = lane >> 3, wc = lane & 7;
    for (int item = gwave; item < 5120; item += nwaves) {
        const bool isin = item < 4096;
        const int it = isin ? item : item - 4096;
        const int l = isin ? (it >> 11) : (it >> 9);
        const int kb = isin ? ((it >> 7) & 15) : ((it >> 5) & 15);
        const int nb = isin ? (it & 127) : (it & 31);
        const float* src = isin ? a.w_in + ((size_t)l * D + kb * 64) * IN_DIM + src_col(nb * 32) + rn
                                : a.w_out + ((size_t)l * D + kb * 64) * D + nb * 32 + rn;
        const size_t sld = isin ? IN_DIM : D;
        float v[32];
#pragma unroll
        for (int r = 0; r < 32; ++r) v[r] = src[(size_t)(2 * r + rk) * sld];
#pragma unroll
        for (int r = 0; r < 32; ++r) tile[(2 * r + rk) * 33 + rn] = v[r];
        asm volatile("s_waitcnt lgkmcnt(0)" ::: "memory");
        float g[8];
        if (isin && l == 1) {
            const float4 g0 = *(const float4*)(a.norm_g + D + kb * 64 + wc * 8), g1 = *(const float4*)(a.norm_g + D + kb * 64 + wc * 8 + 4);
            g[0] = g0.x; g[1] = g0.y; g[2] = g0.z; g[3] = g0.w; g[4] = g1.x; g[5] = g1.y; g[6] = g1.z; g[7] = g1.w;
        } else {
#pragma unroll
            for (int j = 0; j < 8; ++j) g[j] = 1.0f;
        }
        bf16* dst = isin ? win + ((size_t)l * NPROJ + nb * 32) * D + kb * 64 + wc * 8
                         : wout + ((size_t)l * D + nb * 32) * D + kb * 64 + wc * 8;
#pragma unroll
        for (int p = 0; p < 4; ++p) {
            const int n = p * 8 + wn;
            float t[8];
#pragma unroll
            for (int j = 0; j < 8; ++j) t[j] = tile[(wc * 8 + j) * 33 + n] * g[j];
            uint4 o; o.x = pk2(t[0], t[1]); o.y = pk2(t[2], t[3]); o.z = pk2(t[4], t[5]); o.w = pk2(t[6], t[7]);
            *(uint4*)(dst + (size_t)n * D) = o;
        }
        asm volatile("s_waitcnt lgkmcnt(0)" ::: "memory");
    }
    for (int i = gtid; i < 2 * D * 8; i += gthreads) { const int j = i & 7, k = (i >> 3) & (D - 1), l = i >> 13; wf[i] = a.w_in[((size_t)l * D + k) * IN_DIM + 1536 + j] * ((l == 1) ? a.norm_g[D + k] : 1.0f); }
}

__device__ __forceinline__ float log_sigmoid_f(float x) { return -(fmaxf(-x, 0.f) + log1pf(expf(-fabsf(x)))); }
__device__ __forceinline__ void phase_norm(const Args& a, int l, int gwave, int nwaves, int lane) {
    bf16* hn = (bf16*)(a.ws + WS_HN); const float* xp = (const float*)(a.ws + WS_XP); const float* wf = (const float*)(a.ws + WS_WF) + (size_t)l * D * 8;
    const float* g = a.norm_g + (size_t)l * D;
    f32x4 wfr[4][4][2], gg[4];
#pragma unroll
    for (int j = 0; j < 4; ++j) { gg[j] = *(const f32x4*)(g + 4 * lane + 256 * j);
#pragma unroll
        for (int i = 0; i < 4; ++i) { const float* wr = a.w_in + ((size_t)l * D + 4 * lane + 256 * j + i) * IN_DIM + 1536;
            wfr[j][i][0] = *(const f32x4*)wr; wfr[j][i][1] = *(const f32x4*)(wr + 4); } }
    const float bfv = a.b_f[l * H + (lane >> 3)];
    for (int row = gwave; row < MT; row += nwaves) {
        const float* src = (l == 0) ? (row < MP ? a.x_prompt + (size_t)row * D : a.x_sample + (size_t)(row - MP) * D) : xp + (size_t)row * D;
        f32x4 v[4]; float s = 0.f;
#pragma unroll
        for (int j = 0; j < 4; ++j) { v[j] = *(const f32x4*)(src + 4 * lane + 256 * j); s += (v[j].x * v[j].x + v[j].y * v[j].y) + (v[j].z * v[j].z + v[j].w * v[j].w); }
        f32x4 f0 = {0.f, 0.f, 0.f, 0.f}, f1 = {0.f, 0.f, 0.f, 0.f};
#pragma unroll
        for (int j = 0; j < 4; ++j) { v[j] = v[j] * gg[j];
#pragma unroll
            for (int i = 0; i < 4; ++i) { f0 += wfr[j][i][0] * v[j][i]; f1 += wfr[j][i][1] * v[j][i]; } }
        s = wave_sum(s);
        const float k1 = gate_reduce(f0, f1, lane);
        const float rstd = 1.0f / sqrtf(s * (1.0f / D) + EPS);
#pragma unroll
        for (int j = 0; j < 4; ++j) { const f32x4 y = v[j] * rstd; u32x2 w; w.x = pk2(y.x, y.y); w.y = pk2(y.z, y.w); *(u32x2*)(hn + (size_t)row * D + 4 * lane + 256 * j) = w; }
        if ((lane & 7) == 0) {
            const float lf = log_sigmoid_f(k1 * rstd + bfv); const int q = lane >> 3;
            if (row < MP) a.out[O_FLP + ((size_t)l * MP + row) * H + q] = lf;
            else a.out[O_FLS + ((size_t)l * MS + (row - MP)) * H + q] = lf;
        }
    }
}

__device__ __forceinline__ void phase_stats1(const Args& a, int gwave, int nwaves, int lane) {
    const bf16* xb = (const bf16*)(a.ws + WS_XP); const float* wf = (const float*)(a.ws + WS_WF) + (size_t)D * 8; float* rstd_o = (float*)(a.ws + WS_RSTD);
    f32x4 wfr[16][2];
#pragma unroll
    for (int i = 0; i < 16; ++i) { const float* wr = wf + (size_t)(16 * lane + i) * 8; wfr[i][0] = *(const f32x4*)wr; wfr[i][1] = *(const f32x4*)(wr + 4); }
    const float bfv_ = a.b_f[H + (lane >> 3)];
#pragma unroll
    for (int i = 0; i < 16; ++i) asm volatile("" : "+v"(wfr[i][0]), "+v"(wfr[i][1]));
    float bfv = bfv_; asm volatile("" : "+v"(bfv));
    u32x4 n0, n1;
    { const bf16* p0 = xb + (size_t)(gwave < MT ? gwave : 0) * D + 16 * lane;
      asm volatile("global_load_dwordx4 %0, %2, off\n\tglobal_load_dwordx4 %1, %2, off offset:16" : "=&v"(n0), "=&v"(n1) : "v"(p0) : "memory");
      asm volatile("s_waitcnt vmcnt(0)" : "+v"(n0), "+v"(n1) :: "memory"); }
    for (int row = gwave; row < MT; row += nwaves) {
        const u32x4 w0 = n0, w1 = n1;
        { const int nr = (row + nwaves < MT) ? row + nwaves : row;
          const bf16* p0 = xb + (size_t)nr * D + 16 * lane;
          asm volatile("global_load_dwordx4 %0, %2, off\n\tglobal_load_dwordx4 %1, %2, off offset:16" : "=&v"(n0), "=&v"(n1) : "v"(p0) : "memory"); }
        const float v[16] = {bflo(w0.x), bfhi(w0.x), bflo(w0.y), bfhi(w0.y), bflo(w0.z), bfhi(w0.z), bflo(w0.w), bfhi(w0.w),
                             bflo(w1.x), bfhi(w1.x), bflo(w1.y), bfhi(w1.y), bflo(w1.z), bfhi(w1.z), bflo(w1.w), bfhi(w1.w)};
        float s = 0.f; f32x4 f0 = {0.f, 0.f, 0.f, 0.f}, f1 = {0.f, 0.f, 0.f, 0.f};
#pragma unroll
        for (int i = 0; i < 16; ++i) { s += v[i] * v[i]; f0 += wfr[i][0] * v[i]; f1 += wfr[i][1] * v[i]; }
        s = wave_sum(s);
        const float k1 = gate_reduce(f0, f1, lane);
        const float rstd = 1.0f / sqrtf(s * (1.0f / D) + EPS);
        if (lane == 0) rstd_o[row] = rstd;
        if ((lane & 7) == 0) {
            const float lf = log_sigmoid_f(k1 * rstd + bfv); const int q = lane >> 3;
            if (row < MP) a.out[O_FLP + ((size_t)MP + row) * H + q] = lf;
            else a.out[O_FLS + ((size_t)MS + (row - MP)) * H + q] = lf;
        }
        asm volatile("s_waitcnt vmcnt(2)" : "+v"(n0), "+v"(n1) :: "memory");
    }
}

template <int E>
__device__ __forceinline__ void cumsum_wg(const float* src, float* dst, int dstride, f32x4 c0, f32x4 c1, LAS float* tot, int wave, int lane) {
    const int t0 = (wave * 64 + lane) * E;
    f32x4 v[E][2];
#pragma unroll
    for (int i = 0; i < E; ++i) { v[i][0] = *(const f32x4*)(src + (size_t)(t0 + i) * 8); v[i][1] = *(const f32x4*)(src + (size_t)(t0 + i) * 8 + 4); }
    f32x4 r0 = {0.f, 0.f, 0.f, 0.f}, r1 = {0.f, 0.f, 0.f, 0.f};
#pragma unroll
    for (int i = E - 1; i >= 0; --i) { const f32x4 x0 = v[i][0], x1 = v[i][1]; v[i][0] = r0; v[i][1] = r1; r0 += x0; r1 += x1; }
    f32x4 p0 = r0, p1 = r1;
#pragma unroll
    for (int o = 1; o < 64; o <<= 1) {
        f32x4 q0, q1;
#pragma unroll
        for (int j = 0; j < 4; ++j) { q0[j] = __shfl_down(p0[j], o); q1[j] = __shfl_down(p1[j], o); }
        if (lane + o < 64) { p0 += q0; p1 += q1; }
    }
    f32x4 e0, e1;
#pragma unroll
    for (int j = 0; j < 4; ++j) { const float a0 = __shfl_down(p0[j], 1), a1 = __shfl_down(p1[j], 1); e0[j] = lane < 63 ? a0 : 0.f; e1[j] = lane < 63 ? a1 : 0.f; }
    if (lane == 0) { *(LAS f32x4*)(tot + wave * 8) = p0; *(LAS f32x4*)(tot + wave * 8 + 4) = p1; }
    __syncthreads();
#pragma unroll
    for (int w = 1; w < 8; ++w) if (w > wave) { c0 += *(const LAS f32x4*)(tot + w * 8); c1 += *(const LAS f32x4*)(tot + w * 8 + 4); }
    __syncthreads();
    e0 += c0; e1 += c1;
#pragma unroll
    for (int j = 0; j < 4; ++j)
#pragma unroll
        for (int i0 = 0; i0 < E; i0 += 4) {
            f32x4 o0, o1;
#pragma unroll
            for (int i = 0; i < 4; ++i) { o0[i] = (e0[j] + v[i0 + i][0][j]) * LOG2E; o1[i] = (e1[j] + v[i0 + i][1][j]) * LOG2E; }
            *(f32x4*)(dst + (size_t)j * dstride + t0 + i0) = o0; *(f32x4*)(dst + (size_t)(4 + j) * dstride + t0 + i0) = o1;
        }
}
__device__ __forceinline__ void phase_cumsum(const Args& a, int l, LAS unsigned char* lds, int blk, int wave, int lane) {
    if (blk >= NB + DB) return;
    LAS float* tot = (LAS float*)lds;
    const f32x4 z = {0.f, 0.f, 0.f, 0.f};
    if (blk < NB) {
        const int b = blk;
        cumsum_wg<4>(a.out + O_FLP + ((size_t)l * MP + (size_t)b * T) * H, (float*)(a.ws + WS_CKP) + (size_t)(b * 8) * T, T, z, z, tot, wave, lane);
    } else {
        const int b = blk - NB;
        float* cks = (float*)(a.ws + WS_CKS) + (size_t)(b * 8) * SKV;
        f32x4 p0 = z, p1 = z;
        if (lane < DT) { const float* tp = a.out + O_FLS + ((size_t)l * MS + b * DT + lane) * H; p0 = *(const f32x4*)tp; p1 = *(const f32x4*)(tp + 4); }
#pragma unroll
        for (int o = 1; o < DT; o <<= 1) {
            f32x4 q0, q1;
#pragma unroll
            for (int j = 0; j < 4; ++j) { q0[j] = __shfl_down(p0[j], o); q1[j] = __shfl_down(p1[j], o); }
            if (lane + o < DT) { p0 += q0; p1 += q1; }
        }
        f32x4 c0, c1, e0, e1;
#pragma unroll
        for (int j = 0; j < 4; ++j) { c0[j] = __shfl(p0[j], 0); c1[j] = __shfl(p1[j], 0); const float a0 = __shfl_down(p0[j], 1), a1 = __shfl_down(p1[j], 1); e0[j] = a0; e1[j] = a1; }
        if (wave == 0 && lane < DT) {
#pragma unroll
            for (int j = 0; j < 4; ++j) { cks[(size_t)j * SKV + PAST + lane] = (lane < DT - 1 ? e0[j] : 0.f) * LOG2E; cks[(size_t)(4 + j) * SKV + PAST + lane] = (lane < DT - 1 ? e1[j] : 0.f) * LOG2E; }
        }
        cumsum_wg<8>(a.c_fl + ((size_t)l * DB + b) * PAST * H, cks, SKV, c0, c1, tot, wave, lane);
    }
    __syncthreads();
}

struct EpiInProj {
    static constexpr bool PERM = true, AFTER_DRAIN = false, MIDSCALE = false;
    int l; bf16 *qb, *kb, *vb, *zb; float* out; const float* rstd;
    __device__ __forceinline__ void begin(const pg8::Unit&, int) const {}
    __device__ __forceinline__ void operator()(const pg8::f32x4 (&acc_)[2][2][4][2], const pg8::Unit& u, int, int wr, int wc, int fr, int fq) const {
        const int kind = u.pn >> 2, cc0 = (u.pn & 3) * 256 + wc * 32 + 8 * fq;
        const bool samp = (u.pm == MP / 256);
        bf16* bbuf = kind == 0 ? qb : kind == 1 ? kb : kind == 2 ? vb : zb;
        const float sc = kind == 0 ? C2 : 1.0f;
        pg8::f32x4 acc[2][2][4][2];
#pragma unroll
        for (int ai = 0; ai < 2; ++ai)
#pragma unroll
            for (int m = 0; m < 4; ++m) { const float rs = rstd ? rstd[u.pm * 256 + ai * 128 + wr * 64 + m * 16 + fr] : 1.0f;
#pragma unroll
                for (int bj = 0; bj < 2; ++bj)
#pragma unroll
                    for (int n = 0; n < 2; ++n) acc[ai][bj][m][n] = acc_[ai][bj][m][n] * rs; }
#pragma unroll
        for (int ai = 0; ai < 2; ++ai)
#pragma unroll
            for (int m = 0; m < 4; ++m) {
                const int grow = u.pm * 256 + ai * 128 + wr * 64 + m * 16 + fr;
#pragma unroll
                for (int bj = 0; bj < 2; ++bj) {
                    const int cc = cc0 + bj * 128;
                    const pg8::f32x4 v0 = acc[ai][bj][m][0], v1 = acc[ai][bj][m][1];
                    u32x4 w; w.x = pg8::cvt_pk_bf16(v0[0] * sc, v0[1] * sc); w.y = pg8::cvt_pk_bf16(v0[2] * sc, v0[3] * sc); w.z = pg8::cvt_pk_bf16(v1[0] * sc, v1[1] * sc); w.w = pg8::cvt_pk_bf16(v1[2] * sc, v1[3] * sc);
                    *(u32x4*)(bbuf + (size_t)grow * D + cc) = w;
                    if (out && (kind == 1 || kind == 2)) {
                        const bool grpB = cc >= W; const int c5 = cc & (W - 1);
                        size_t o;
                        if (!samp) o = (kind == 1 ? (grpB ? O_SKP : O_FKP) : (grpB ? O_SVP : O_FVP)) + ((size_t)l * MP + grow) * W + c5;
                        else o = (kind == 1 ? (grpB ? O_SKS : O_FKS) : (grpB ? O_SVS : O_FVS)) + ((size_t)l * MS + (grow - MP)) * W + c5;
                        *(pg8::f32x4*)(out + o) = v0; *(pg8::f32x4*)(out + o + 4) = v1;
                    }
                }
            }
    }
};
struct EpiOutProj {
    static constexpr bool PERM = true, AFTER_DRAIN = false, MIDSCALE = true;
    int l; const float* xin_p; const float* xin_s; const float* ssq; float* xp; LAS float* tab;
    __device__ __forceinline__ void begin(const pg8::Unit& u, int ui) const {
        const int tid = threadIdx.x;
        if (tid < 256) {
            const float* sq = ssq + (size_t)(u.pm * 256 + tid) * 16;
            const pg8::f32x4 a0 = *(const pg8::f32x4*)sq, a1 = *(const pg8::f32x4*)(sq + 4), b0 = *(const pg8::f32x4*)(sq + 8), b1 = *(const pg8::f32x4*)(sq + 12);
            const float sa = ((a0[0] + a0[1]) + (a0[2] + a0[3])) + ((a1[0] + a1[1]) + (a1[2] + a1[3]));
            const float sb = ((b0[0] + b0[1]) + (b0[2] + b0[3])) + ((b1[0] + b1[1]) + (b1[2] + b1[3]));
            const float rA = 1.0f / sqrtf(sa * (1.0f / W) + EPS), rB = 1.0f / sqrtf(sb * (1.0f / W) + EPS);
            LAS float* t = tab + ((ui & 1) * 256 + tid) * 2; t[0] = rA / rB; t[1] = rB;
        }
    }
    __device__ __forceinline__ void mid(pg8::f32x4 (&acc)[2][2][4][2], const pg8::Unit&, int ui, int wr, int fr) const {
#pragma unroll
        for (int ai = 0; ai < 2; ++ai)
#pragma unroll
            for (int m = 0; m < 4; ++m) {
                const float ratio = tab[((ui & 1) * 256 + ai * 128 + wr * 64 + m * 16 + fr) * 2];
#pragma unroll
                for (int bj = 0; bj < 2; ++bj)
#pragma unroll
                    for (int n = 0; n < 2; ++n) acc[ai][bj][m][n] *= ratio;
            }
    }
    __device__ __forceinline__ void operator()(const pg8::f32x4 (&acc)[2][2][4][2], const pg8::Unit& u, int ui, int wr, int wc, int fr, int fq) const {
        const size_t off0 = ((size_t)u.pm * 256 + wr * 64 + fr) * D + u.pn * 256 + wc * 32 + 8 * fq;
        const LAS float* tb = tab + ((ui & 1) * 256 + wr * 64 + fr) * 2 + 1;
        bf16* xb = (bf16*)xp;
#pragma unroll
        for (int ai = 0; ai < 2; ++ai) {
            pg8::f32x4 x[4][2][2];
#pragma unroll
            for (int m = 0; m < 4; ++m) { const size_t ro = off0 + (size_t)(ai * 128 + m * 16) * D;
#pragma unroll
                for (int bj = 0; bj < 2; ++bj) {
                    if (l == 0) { x[m][bj][0] = *(const pg8::f32x4*)(xin_p + ro + bj * 128); x[m][bj][1] = *(const pg8::f32x4*)(xin_p + ro + bj * 128 + 4); }
                    else { const u32x4 w = *(const u32x4*)(xb + ro + bj * 128);
                           x[m][bj][0] = (pg8::f32x4){bflo(w.x), bfhi(w.x), bflo(w.y), bfhi(w.y)}; x[m][bj][1] = (pg8::f32x4){bflo(w.z), bfhi(w.z), bflo(w.w), bfhi(w.w)}; } } }
#pragma unroll
            for (int m = 0; m < 4; ++m) { const size_t ro = off0 + (size_t)(ai * 128 + m * 16) * D; const float rB = tb[(ai * 128 + m * 16) * 2];
#pragma unroll
                for (int bj = 0; bj < 2; ++bj) {
                    const pg8::f32x4 y0 = x[m][bj][0] + acc[ai][bj][m][0] * rB, y1 = x[m][bj][1] + acc[ai][bj][m][1] * rB;
                    u32x4 o; o.x = pg8::cvt_pk_bf16(y0[0], y0[1]); o.y = pg8::cvt_pk_bf16(y0[2], y0[3]); o.z = pg8::cvt_pk_bf16(y1[0], y1[1]); o.w = pg8::cvt_pk_bf16(y1[2], y1[3]);
                    *(u32x4*)(xb + ro + bj * 128) = o; } }
            asm volatile("" ::: "memory");
        }
    }
};

typedef short sg_bf16x8 __attribute__((ext_vector_type(8)));
template <bool SPLIT, class Epi>
__device__ __forceinline__ void small_gemm(const bf16* A  , const bf16* Bt  , int N, const Epi& E, int unit) {
    int tid_ = threadIdx.x; asm volatile("" : "+v"(tid_));
    const int tid = tid_, lane = tid & 63, wid = __builtin_amdgcn_readfirstlane(tid >> 6), wr = wid >> 1, wc = wid & 1;
    if (unit >= 4 * (N / 64)) return;
    const int tm = unit & 3, tn = unit >> 2;
    const int row = tm * 64 + wr * 16 + (lane & 15), n0 = tn * 64 + wc * 32, kq = 8 * (lane >> 4);
    const bf16* xa = A + (size_t)row * D + kq;
    const bf16* w0 = Bt + (size_t)(n0 + (lane & 15)) * D + kq; const bf16* w1 = w0 + (size_t)16 * D;
    f32x4 acc[2][2];
#pragma unroll
    for (int i = 0; i < 2; ++i)
#pragma unroll
        for (int j = 0; j < 2; ++j) acc[i][j] = (f32x4){0.f, 0.f, 0.f, 0.f};
#pragma unroll 1
    for (int k0 = 0; k0 < D; k0 += 512) {
        sg_bf16x8 xf[16], wf0[16], wf1[16];
#pragma unroll
        for (int i = 0; i < 16; ++i) { xf[i] = *(const sg_bf16x8*)(xa + k0 + 32 * i); wf0[i] = *(const sg_bf16x8*)(w0 + k0 + 32 * i); wf1[i] = *(const sg_bf16x8*)(w1 + k0 + 32 * i); }
        const int hsel = (SPLIT && k0 >= 512) ? 1 : 0;
#pragma unroll
        for (int i = 0; i < 16; ++i) {
            if (hsel) { acc[1][0] = __builtin_amdgcn_mfma_f32_16x16x32_bf16(wf0[i], xf[i], acc[1][0], 0, 0, 0); acc[1][1] = __builtin_amdgcn_mfma_f32_16x16x32_bf16(wf1[i], xf[i], acc[1][1], 0, 0, 0); }
            else { acc[0][0] = __builtin_amdgcn_mfma_f32_16x16x32_bf16(wf0[i], xf[i], acc[0][0], 0, 0, 0); acc[0][1] = __builtin_amdgcn_mfma_f32_16x16x32_bf16(wf1[i], xf[i], acc[0][1], 0, 0, 0); }
        }
    }
#pragma unroll
    for (int t = 0; t < 2; ++t) E(row, n0 + 16 * t + 4 * (lane >> 4), acc[0][t], acc[1][t]);
}
struct EpiInS {
    int l; bf16 *qb, *kb, *vb, *zb; float* out; const float* rstd;
    __device__ __forceinline__ void operator()(int row, int n, const f32x4& c_, const f32x4&) const {
        const int kind = n >> 10, cc = n & 1023; const size_t grow = (size_t)MP + row;
        const f32x4 c = c_ * (rstd ? rstd[grow] : 1.0f);
        u32x2 w;
        if (kind == 0) { w.x = pk2(c[0] * C2, c[1] * C2); w.y = pk2(c[2] * C2, c[3] * C2); *(u32x2*)(qb + grow * D + cc) = w; return; }
        w.x = pk2(c[0], c[1]); w.y = pk2(c[2], c[3]);
        if (kind == 3) { *(u32x2*)(zb + grow * D + cc) = w; return; }
        *(u32x2*)((kind == 1 ? kb : vb) + grow * D + cc) = w;
        const bool grpB = cc >= W; const int c5 = cc & (W - 1);
        const size_t o = (kind == 1 ? (grpB ? O_SKS : O_FKS) : (grpB ? O_SVS : O_FVS)) + ((size_t)l * MS + row) * W + c5;
        *(f32x4*)(out + o) = c;
    }
};
struct EpiOutS {
    int l; const float* xin_s; const float* ssq; float* xp;
    __device__ __forceinline__ void operator()(int row, int n, const f32x4& ca, const f32x4& cb) const {
        const size_t grow = (size_t)MP + row;
        const float* sq = ssq + grow * 16; float sa = 0.f, sb = 0.f;
#pragma unroll
        for (int h = 0; h < 8; ++h) { sa += sq[h]; sb += sq[8 + h]; }
        const float rA = 1.0f / sqrtf(sa * (1.0f / W) + EPS), rB = 1.0f / sqrtf(sb * (1.0f / W) + EPS);
        bf16* xb = (bf16*)xp; f32x4 xv;
        if (l == 0) xv = *(const f32x4*)(xin_s + (size_t)row * D + n);
        else { const u32x2 w = *(const u32x2*)(xb + grow * D + n); xv = (f32x4){bflo(w.x), bfhi(w.x), bflo(w.y), bfhi(w.y)}; }
        const f32x4 y = xv + ca * rA + cb * rB;
        u32x2 o; o.x = pk2(y[0], y[1]); o.y = pk2(y[2], y[3]); *(u32x2*)(xb + grow * D + n) = o;
    }
};

template <bool SPLIT, class Epi>
__device__ __forceinline__ void naive_gemm(LAS unsigned char* lds, const bf16* A, const bf16* Bt, int M, int N, int K, const Epi& E, int blk, int nblk) {
    LAS float* As = (LAS float*)lds;
    LAS float* Bs = (LAS float*)(lds + 16 * 132 * 4);
    const int tid = threadIdx.x, tx = tid & 15, ty = tid >> 4;
    const int ntm = M / 128, ntn = N / 64;
    for (int tile = blk; tile < ntm * ntn; tile += nblk) {
        const int tm = tile / ntn, tn = tile % ntn, m0 = tm * 128, n0 = tn * 64;
        float acc[4][4], acc2[4][4];
#pragma unroll
        for (int i = 0; i < 4; ++i)
#pragma unroll
            for (int j = 0; j < 4; ++j) { acc[i][j] = 0.f; acc2[i][j] = 0.f; }
        for (int k0 = 0; k0 < K; k0 += 16) {
            { const int r = tid >> 2, kq = (tid & 3) * 4; const u32x2 w = *(const u32x2*)(A + (size_t)(m0 + r) * K + k0 + kq);
              As[(kq + 0) * 132 + r] = bflo(w.x); As[(kq + 1) * 132 + r] = bfhi(w.x); As[(kq + 2) * 132 + r] = bflo(w.y); As[(kq + 3) * 132 + r] = bfhi(w.y); }
            if (tid < 256) { const int r = tid >> 2, kq = (tid & 3) * 4; const u32x2 w = *(const u32x2*)(Bt + (size_t)(n0 + r) * K + k0 + kq);
              Bs[(kq + 0) * 68 + r] = bflo(w.x); Bs[(kq + 1) * 68 + r] = bfhi(w.x); Bs[(kq + 2) * 68 + r] = bflo(w.y); Bs[(kq + 3) * 68 + r] = bfhi(w.y); }
            __syncthreads();
            const bool second = SPLIT && (k0 >= 512);
#pragma unroll
            for (int kk = 0; kk < 16; ++kk) {
                const f32x4 av = *(const LAS f32x4*)(As + kk * 132 + ty * 4), bv = *(const LAS f32x4*)(Bs + kk * 68 + tx * 4);
                if (second) {
#pragma unroll
                    for (int i = 0; i < 4; ++i)
#pragma unroll
                        for (int j = 0; j < 4; ++j) acc2[i][j] += av[i] * bv[j];
                } else {
#pragma unroll
                    for (int i = 0; i < 4; ++i)
#pragma unroll
                        for (int j = 0; j < 4; ++j) acc[i][j] += av[i] * bv[j];
                }
            }
            __syncthreads();
        }
#pragma unroll
        for (int i = 0; i < 4; ++i) E(m0 + ty * 4 + i, n0 + tx * 4, acc[i], acc2[i]);
    }
}
struct EpiIn {
    int l; bf16 *qb, *kb, *vb, *zb; float* out;
    __device__ __forceinline__ void operator()(int row, int n, const float (&c)[4], const float (&)[4]) const {
        const int j = n >> 9, cc = n & 1023;
        const int kind = n >> 10;
        u32x2 w;
        if (kind == 0) { w.x = pk2(c[0] * C2, c[1] * C2); w.y = pk2(c[2] * C2, c[3] * C2); *(u32x2*)(qb + (size_t)row * D + cc) = w; return; }
        w.x = pk2(c[0], c[1]); w.y = pk2(c[2], c[3]);
        if (kind == 3) { *(u32x2*)(zb + (size_t)row * D + cc) = w; return; }
        *(u32x2*)((kind == 1 ? kb : vb) + (size_t)row * D + cc) = w;
        const bool grpB = (j & 1); const int c5 = n & 511;
        size_t o;
        if (row < MP) o = (kind == 1 ? (grpB ? O_SKP : O_FKP) : (grpB ? O_SVP : O_FVP)) + ((size_t)l * MP + row) * W + c5;
        else o = (kind == 1 ? (grpB ? O_SKS : O_FKS) : (grpB ? O_SVS : O_FVS)) + ((size_t)l * MS + (row - MP)) * W + c5;
        *(f32x4*)(out + o) = (f32x4){c[0], c[1], c[2], c[3]};
    }
};
struct EpiOut {
    int l; const float* xin_p; const float* xin_s; const float* ssq; float* xp;
    __device__ __forceinline__ void operator()(int row, int n, const float (&ca)[4], const float (&cb)[4]) const {
        const float* sq = ssq + (size_t)row * 16; float sa = 0.f, sb = 0.f;
#pragma unroll
        for (int h = 0; h < 8; ++h) { sa += sq[h]; sb += sq[8 + h]; }
        const float rA = 1.0f / sqrtf(sa * (1.0f / W) + EPS), rB = 1.0f / sqrtf(sb * (1.0f / W) + EPS);
        const float* xin = (l == 0) ? (row < MP ? xin_p + (size_t)row * D : xin_s + (size_t)(row - MP) * D) : xp + (size_t)row * D;
        const f32x4 xv = *(const f32x4*)(xin + n);
        f32x4 o;
#pragma unroll
        for (int i = 0; i < 4; ++i) o[i] = xv[i] + rA * ca[i] + rB * cb[i];
        *(f32x4*)(xp + (size_t)row * D + n) = o;
    }
};

__device__ __forceinline__ float silu_f(float z) { return z / (1.0f + expf(-z)); }
template <int NE> __device__ __forceinline__ void load_row_bf16(const bf16* p, float (&v)[NE]) {
#pragma unroll
    for (int c = 0; c < NE / 8; ++c) { const u32x4 w = *(const u32x4*)(p + 8 * c);
        v[8 * c + 0] = bflo(w.x); v[8 * c + 1] = bfhi(w.x); v[8 * c + 2] = bflo(w.y); v[8 * c + 3] = bfhi(w.y);
        v[8 * c + 4] = bflo(w.z); v[8 * c + 5] = bfhi(w.z); v[8 * c + 6] = bflo(w.w); v[8 * c + 7] = bfhi(w.w); }
}
template <int NE> __device__ __forceinline__ float dot_row_bf16(const bf16* p, const float (&q)[NE]) {
    float s0 = 0.f, s1 = 0.f;
#pragma unroll
    for (int c = 0; c < NE / 8; ++c) { if ((c & 3) == 0) asm volatile("" ::: "memory"); const u32x4 w = *(const u32x4*)(p + 8 * c);
        s0 += q[8 * c + 0] * bflo(w.x); s1 += q[8 * c + 1] * bfhi(w.x); s0 += q[8 * c + 2] * bflo(w.y); s1 += q[8 * c + 3] * bfhi(w.y);
        s0 += q[8 * c + 4] * bflo(w.z); s1 += q[8 * c + 5] * bfhi(w.z); s0 += q[8 * c + 6] * bflo(w.w); s1 += q[8 * c + 7] * bfhi(w.w); }
    return s0 + s1;
}
template <int NE> __device__ __forceinline__ void axpy_row_bf16(const bf16* p, float a, float (&o)[NE]) {
#pragma unroll
    for (int c = 0; c < NE / 8; ++c) { if ((c & 3) == 0) asm volatile("" ::: "memory"); const u32x4 w = *(const u32x4*)(p + 8 * c);
        o[8 * c + 0] += a * bflo(w.x); o[8 * c + 1] += a * bfhi(w.x); o[8 * c + 2] += a * bflo(w.y); o[8 * c + 3] += a * bfhi(w.y);
        o[8 * c + 4] += a * bflo(w.z); o[8 * c + 5] += a * bfhi(w.z); o[8 * c + 6] += a * bflo(w.w); o[8 * c + 7] += a * bfhi(w.w); }
}
__device__ __forceinline__ float rbf(float x) { return bf2f(f2bf(x)); }
template <int NE> __device__ __forceinline__ float dot_row_f32(const float* p, const float (&q)[NE]) {
    float s0 = 0.f, s1 = 0.f;
#pragma unroll
    for (int c = 0; c < NE / 4; ++c) { if ((c & 3) == 0) asm volatile("" ::: "memory"); const f32x4 w = *(const f32x4*)(p + 4 * c);
        s0 += q[4 * c + 0] * rbf(w.x); s1 += q[4 * c + 1] * rbf(w.y); s0 += q[4 * c + 2] * rbf(w.z); s1 += q[4 * c + 3] * rbf(w.w); }
    return s0 + s1;
}
template <int NE> __device__ __forceinline__ void axpy_row_f32(const float* p, float a, float (&o)[NE]) {
#pragma unroll
    for (int c = 0; c < NE / 4; ++c) { if ((c & 3) == 0) asm volatile("" ::: "memory"); const f32x4 w = *(const f32x4*)(p + 4 * c);
        o[4 * c + 0] += a * rbf(w.x); o[4 * c + 1] += a * rbf(w.y); o[4 * c + 2] += a * rbf(w.z); o[4 * c + 3] += a * rbf(w.w); }
}
template <int NE> __device__ __forceinline__ float gate_store(const Args& a, int l, int g, int colg, int row, const float (&o)[NE]) {
    const bf16* zb = (const bf16*)(a.ws + WS_Z) + (size_t)row * D + g * W + colg;
    bf16* og = (bf16*)(a.ws + WS_HN) + (size_t)row * D + g * W + colg;
    const float* gn = (g == 0 ? a.gn_a : a.gn_b) + (size_t)l * W + colg;
    float ssq = 0.f;
#pragma unroll
    for (int c = 0; c < NE / 8; ++c) { float r[8]; asm volatile("" ::: "memory");
        const u32x4 zw = *(const u32x4*)(zb + 8 * c);
        const float zz[8] = {bflo(zw.x), bfhi(zw.x), bflo(zw.y), bfhi(zw.y), bflo(zw.z), bfhi(zw.z), bflo(zw.w), bfhi(zw.w)};
#pragma unroll
        for (int i = 0; i < 8; ++i) { const float ov = o[8 * c + i]; ssq += ov * ov; r[i] = ov * gn[8 * c + i] * silu_f(zz[i]); }
        u32x4 w; w.x = pk2(r[0], r[1]); w.y = pk2(r[2], r[3]); w.z = pk2(r[4], r[5]); w.w = pk2(r[6], r[7]);
        *(u32x4*)(og + 8 * c) = w; }
    return ssq;
}
__device__ __forceinline__ float sb_logsig_neg2(float z2) {
    return -(fmaxf(z2, 0.f) + __log2f(1.0f + exp2f(-fabsf(z2))));
}
__device__ __forceinline__ float rhalf(float x) { return (float)(_Float16)x; }
__device__ __forceinline__ void attn_prompt_naive(const Args& a, int l, int gtid, int gthreads) {
    const bf16* qb = (const bf16*)(a.ws + WS_Q); const bf16* kb = (const bf16*)(a.ws + WS_K); const bf16* vb = (const bf16*)(a.ws + WS_V);
    const float* ckp = (const float*)(a.ws + WS_CKP);
    for (int it = gtid; it < 2 * NB * H * T; it += gthreads) {
        const int t = it & (T - 1), h = (it >> 11) & 7, b = (it >> 14) & 31, g = it >> 19;
        const int row = b * T + t, col = g * W + h * HD;
        float q[64], o[64]; load_row_bf16<64>(qb + (size_t)row * D + col, q);
#pragma unroll
        for (int d = 0; d < 64; ++d) o[d] = 0.f;
        const bf16* kp = kb + (size_t)b * T * D + col; const bf16* vp = vb + (size_t)b * T * D + col;
        const int tmax = t | 63;
        if (g == 0) {
            const float* ck = ckp + (size_t)(b * 8 + h) * T;
            float m = -1e30f, lsum = 0.f;
            for (int s = 0; s <= tmax; ++s) {
                const float x = dot_row_bf16<64>(kp + (size_t)s * D, q) + ck[s];
                if (s <= t) {
                    const float mn = fmaxf(m, x), al = exp2f(m - mn), p = exp2f(x - mn);
                    lsum = lsum * al + p; m = mn;
#pragma unroll
                    for (int d = 0; d < 64; ++d) o[d] *= al;
                    axpy_row_bf16<64>(vp + (size_t)s * D, rbf(p), o);
                }
            }
            const float inv = 1.0f / lsum;
#pragma unroll
            for (int d = 0; d < 64; ++d) o[d] *= inv;
        } else {
            float R = 0.f;
            for (int s = tmax - 1; s >= 0; --s) {
                const float z2 = dot_row_bf16<64>(kp + (size_t)s * D, q);
                if (s < t) {
                    const float L2 = sb_logsig_neg2(z2), A = exp2f(z2 + L2 + R);
                    axpy_row_bf16<64>(vp + (size_t)s * D, rbf(A), o);
                    R += rhalf(L2);
                }
            }
        }
        const float ssq = gate_store<64>(a, l, g, h * HD, row, o);
        ((float*)(a.ws + WS_SSQ))[(size_t)row * 16 + g * 8 + h] = ssq;
    }
}
__device__ __forceinline__ void attn_sample_naive(const Args& a, int l, int gtid, int gthreads) {
    const bf16* qb = (const bf16*)(a.ws + WS_Q); const bf16* kb = (const bf16*)(a.ws + WS_K); const bf16* vb = (const bf16*)(a.ws + WS_V);
    const float* cks = (const float*)(a.ws + WS_CKS);
    for (int it2 = gtid; it2 < 2 * 2 * DB * H * DT; it2 += gthreads) {
        const int hf = it2 & 1, it = it2 >> 1;
        const int t = it & 15, h = (it >> 4) & 7, b = (it >> 7) & 15, g = it >> 11;
        const int row = MP + b * DT + t, col = g * W + h * HD + hf * 32;
        float q[32], o[32]; load_row_bf16<32>(qb + (size_t)row * D + col, q);
#pragma unroll
        for (int d = 0; d < 32; ++d) o[d] = 0.f;
        const float* ck_c = (g == 0 ? a.c_fk : a.c_sk) + (((size_t)l * DB + b) * PAST) * W + h * HD + hf * 32;
        const float* cv_c = (g == 0 ? a.c_fv : a.c_sv) + (((size_t)l * DB + b) * PAST) * W + h * HD + hf * 32;
        const bf16* kn = kb + (size_t)(MP + b * DT) * D + col; const bf16* vn = vb + (size_t)(MP + b * DT) * D + col;
        if (g == 0) {
            const float* ck = cks + (size_t)(b * 8 + h) * SKV;
            float m = -1e30f, lsum = 0.f;
#define FOX_UPD(x, VAXPY) do { const float mn = fmaxf(m, (x)), al = exp2f(m - mn), p = exp2f((x) - mn); lsum = lsum * al + p; m = mn; \
    _Pragma("unroll") for (int d = 0; d < 32; ++d) o[d] *= al; VAXPY; } while (0)
            for (int s = 0; s < PAST; ++s) {
                float x = dot_row_f32<32>(ck_c + (size_t)s * W, q); x += __shfl_xor(x, 1); x += ck[s];
                FOX_UPD(x, axpy_row_f32<32>(cv_c + (size_t)s * W, rbf(p), o));
            }
            for (int j = 0; j < DT; ++j) {
                float x = dot_row_bf16<32>(kn + (size_t)j * D, q); x += __shfl_xor(x, 1); x += ck[PAST + j];
                if (j <= t) FOX_UPD(x, axpy_row_bf16<32>(vn + (size_t)j * D, rbf(p), o));
            }
#undef FOX_UPD
            const float inv = 1.0f / lsum;
#pragma unroll
            for (int d = 0; d < 32; ++d) o[d] *= inv;
        } else {
            float R = 0.f;
            for (int j = DT - 1; j >= 0; --j) {
                float z2 = dot_row_bf16<32>(kn + (size_t)j * D, q); z2 += __shfl_xor(z2, 1);
                if (j < t) { const float L2 = sb_logsig_neg2(z2), A = exp2f(z2 + L2 + R); axpy_row_bf16<32>(vn + (size_t)j * D, rbf(A), o); R += rhalf(L2); }
            }
            for (int s = PAST - 1; s >= 0; --s) {
                float z2 = dot_row_f32<32>(ck_c + (size_t)s * W, q); z2 += __shfl_xor(z2, 1);
                const float L2 = sb_logsig_neg2(z2), A = exp2f(z2 + L2 + R);
                axpy_row_f32<32>(cv_c + (size_t)s * W, rbf(A), o); R += rhalf(L2);
            }
        }
        float ssq = gate_store<32>(a, l, g, h * HD + hf * 32, row, o); ssq += __shfl_xor(ssq, 1);
        if (hf == 0) ((float*)(a.ws + WS_SSQ))[(size_t)row * 16 + g * 8 + h] = ssq;
    }
}

namespace att {
typedef short bf16x8 __attribute__((ext_vector_type(8)));
typedef _Float16 f16x8 __attribute__((ext_vector_type(8)));
typedef _Float16 f16x2 __attribute__((ext_vector_type(2)));
typedef float f32x16 __attribute__((ext_vector_type(16)));
typedef float f32x2 __attribute__((ext_vector_type(2)));
typedef __bf16 bf16x2_t __attribute__((ext_vector_type(2)));
typedef short s16x4 __attribute__((ext_vector_type(4)));
typedef LAS const char* lds_cptr;
constexpr float NEG = -1.0e30f;
constexpr float R_DONE = -151.0f;
constexpr int NSLOT = 4, A_K = 0, A_V = 32768, A_CK = 65536, A_WSF = 73728, A_FLAG = 75776, A_STG = 0;
constexpr int S_WSF = 132096, S_XT = 134144, S_ML = 136192, A_UNIT = 138240;

__device__ __forceinline__ int crow(int r, int hi) { return (r & 3) + 8 * (r >> 2) + 4 * hi; }
__device__ __forceinline__ void glds16(const void* gsrc, unsigned lds_dst) { unsigned keep;
    asm volatile("s_mov_b32 %0, m0\n\ts_mov_b32 m0, %2\n\ts_nop 0\n\tglobal_load_lds_dwordx4 %1, off\n\ts_mov_b32 m0, %0" : "=&s"(keep) : "v"(gsrc), "s"(lds_dst) : "memory"); }
__device__ __forceinline__ unsigned cvtpk(float lo, float hi) { f32x2 v = {lo, hi}; bf16x2_t b = __builtin_convertvector(v, bf16x2_t); return __builtin_bit_cast(unsigned, b); }
__device__ __forceinline__ unsigned cvtpk_h(float lo, float hi) { f32x2 v = {lo, hi}; f16x2 b = __builtin_convertvector(v, f16x2); return __builtin_bit_cast(unsigned, b); }
__device__ __forceinline__ float swap_max(float m) { auto rr = __builtin_amdgcn_permlane32_swap(__float_as_uint(m), __float_as_uint(m), false, false); return fmaxf(__uint_as_float(rr[0]), __uint_as_float(rr[1])); }
__device__ __forceinline__ float swap_sum(float m) { auto rr = __builtin_amdgcn_permlane32_swap(__float_as_uint(m), __float_as_uint(m), false, false); return __uint_as_float(rr[0]) + __uint_as_float(rr[1]); }
__device__ __forceinline__ float max3f(float a, float b, float c) { return __builtin_fmaxf(__builtin_fmaxf(a, b), c); }
__device__ __forceinline__ float fadd_s(float a, float b) { float r = a + b; asm volatile("" : "+v"(r)); return r; }
#define ATT_WAIT_BAR() asm volatile("s_waitcnt vmcnt(0) lgkmcnt(0)\n\ts_barrier" ::: "memory")
#define ATT_WAIT_BAR_N(N) asm volatile("s_waitcnt vmcnt(" #N ") lgkmcnt(0)\n\ts_barrier" ::: "memory")
#define ATT_LDS_WAIT() asm volatile("s_waitcnt lgkmcnt(0)" ::: "memory")

__device__ __forceinline__ void kfrags(bf16x8 (&kf)[8], lds_cptr kslot, int r32, int hi) {
    lds_cptr kb = kslot + hi * 1024 + r32 * 16;
#pragma unroll
    for (int d0 = 0; d0 < 4; ++d0) { kf[2 * d0] = *(const LAS bf16x8*)(kb + d0 * 2048); kf[2 * d0 + 1] = *(const LAS bf16x8*)(kb + d0 * 2048 + 512); }
}
__device__ __forceinline__ s16x4 vtr(lds_cptr p) { return __builtin_bit_cast(s16x4, __builtin_amdgcn_ds_read_tr16_b64_v4i16((LAS s16x4*)p)); }
struct VFrags { s16x4 lo[8], hh[8]; };
__device__ __forceinline__ void vfrags(VFrags& v, lds_cptr vp) {
#pragma unroll
    for (int i = 0; i < 8; ++i) { v.lo[i] = vtr(vp + (i >> 2) * 4096 + (i & 3) * 1024); v.hh[i] = vtr(vp + (i >> 2) * 4096 + (i & 3) * 1024 + 512); }
}
__device__ __forceinline__ void pv(f32x16 (&o)[2], const VFrags& v, const u32x4& pw0, const u32x4& pw1, const u32x4& pw2, const u32x4& pw3) {
#define ATT_VF(k) (bf16x8){v.lo[k][0], v.lo[k][1], v.lo[k][2], v.lo[k][3], v.hh[k][0], v.hh[k][1], v.hh[k][2], v.hh[k][3]}
    o[0] = __builtin_amdgcn_mfma_f32_32x32x16_bf16(__builtin_bit_cast(bf16x8, pw0), ATT_VF(0), o[0], 0, 0, 0);
    o[1] = __builtin_amdgcn_mfma_f32_32x32x16_bf16(__builtin_bit_cast(bf16x8, pw0), ATT_VF(4), o[1], 0, 0, 0);
    o[0] = __builtin_amdgcn_mfma_f32_32x32x16_bf16(__builtin_bit_cast(bf16x8, pw1), ATT_VF(1), o[0], 0, 0, 0);
    o[1] = __builtin_amdgcn_mfma_f32_32x32x16_bf16(__builtin_bit_cast(bf16x8, pw1), ATT_VF(5), o[1], 0, 0, 0);
    o[0] = __builtin_amdgcn_mfma_f32_32x32x16_bf16(__builtin_bit_cast(bf16x8, pw2), ATT_VF(2), o[0], 0, 0, 0);
    o[1] = __builtin_amdgcn_mfma_f32_32x32x16_bf16(__builtin_bit_cast(bf16x8, pw2), ATT_VF(6), o[1], 0, 0, 0);
    o[0] = __builtin_amdgcn_mfma_f32_32x32x16_bf16(__builtin_bit_cast(bf16x8, pw3), ATT_VF(3), o[0], 0, 0, 0);
    o[1] = __builtin_amdgcn_mfma_f32_32x32x16_bf16(__builtin_bit_cast(bf16x8, pw3), ATT_VF(7), o[1], 0, 0, 0);
#undef ATT_VF
}
#define ATT_PACK4(P, B, F) (u32x4){F(P[B], P[B + 1]), F(P[B + 2], P[B + 3]), F(P[B + 4], P[B + 5]), F(P[B + 6], P[B + 7])}
__device__ __forceinline__ f32x4 ld4(const LAS float* p) { return *(const LAS f32x4*)p; }
__device__ __forceinline__ f32x4 ld4(const float* p) { return *(const f32x4*)p; }

constexpr float FOX_THR = 8.0f;
constexpr float FOX_BIG = 1048576.0f;
struct FoxState { float m, l; bf16x8 mq; f32x16 o[2]; };
__device__ __forceinline__ float bf_hi_part(float x) { return __uint_as_float(cvtpk(x, 0.f) << 16); }
__device__ __forceinline__ bf16x8 make_mq(float m, int hi) {
    const float h1 = bf_hi_part(m), r1 = m - h1, h2 = bf_hi_part(r1), r2 = r1 - h2;
    u32x4 w = {0x3F803F80u, cvtpk(1.0f, h1), cvtpk(h2, r2), 0u};
    if (hi) { w.x = 0u; w.y = 0u; w.z = 0u; }
    return __builtin_bit_cast(bf16x8, w);
}
template <int LEVEL = 9, class CP>
__device__ __forceinline__ void fox_tile(FoxState& st, lds_cptr kslot, lds_cptr vp, const bf16x8 (&qr)[4], CP ckt  , bool masked, bool first, int qlim, int r32, int hi, LAS float* wsf) {
    bf16x8 kf[8]; kfrags(kf, kslot, r32, hi);
    f32x16 p0, p1;
#pragma unroll
    for (int g = 0; g < 4; ++g) { const f32x4 c0 = ld4(ckt + 8 * g), c1 = ld4(ckt + 32 + 8 * g);
#pragma unroll
        for (int i = 0; i < 4; ++i) { p0[4 * g + i] = c0[i]; p1[4 * g + i] = c1[i]; } }
    u32x4 kn = {0u, 0xBF800000u, 0xBF80BF80u, 0u}; if (hi) { kn.y = 0u; kn.z = 0u; }
    const bf16x8 kneg = __builtin_bit_cast(bf16x8, kn);
    p0 = __builtin_amdgcn_mfma_f32_32x32x16_bf16(kneg, st.mq, p0, 0, 0, 0);
    p1 = __builtin_amdgcn_mfma_f32_32x32x16_bf16(kneg, st.mq, p1, 0, 0, 0);
#pragma unroll
    for (int d0 = 0; d0 < 4; ++d0) {
        p0 = __builtin_amdgcn_mfma_f32_32x32x16_bf16(kf[2 * d0], qr[d0], p0, 0, 0, 0);
        p1 = __builtin_amdgcn_mfma_f32_32x32x16_bf16(kf[2 * d0 + 1], qr[d0], p1, 0, 0, 0);
    }
    __builtin_amdgcn_sched_barrier(0);
    if (LEVEL == 2) { asm volatile("" :: "v"(p0), "v"(p1)); return; }
    if (masked) {
        asm volatile("; masked tile" ::: "memory");
#pragma unroll
        for (int r = 0; r < 16; ++r) { const int kv = crow(r, hi); if (kv >= qlim) p0[r] = NEG; if (kv + 32 >= qlim) p1[r] = NEG; }
    }
    float rm = max3f(p0[0], p1[0], p0[1]), rm2 = max3f(p1[1], p0[2], p1[2]);
#pragma unroll
    for (int r = 3; r < 15; r += 2) { rm = max3f(rm, p0[r], p1[r]); rm2 = max3f(rm2, p0[r + 1], p1[r + 1]); }
    rm = max3f(rm, p0[15], p1[15]); rm = swap_max(max3f(rm, rm2, rm2));
    if (first || __any(rm > FOX_THR)) {
        const float dl = first ? rm : fmaxf(rm, 0.f);
        st.m += dl; st.mq = make_mq(st.m, hi);
#pragma unroll
        for (int r = 0; r < 16; ++r) { p0[r] -= dl; p1[r] -= dl; }
        if (!first) {
            const float f = __builtin_amdgcn_exp2f(-dl);
            st.l *= f;
            if (hi == 0) wsf[r32] = f;
            ATT_LDS_WAIT();
#pragma unroll
            for (int g = 0; g < 4; ++g) { const f32x4 fv = *(const LAS f32x4*)(wsf + 8 * g + 4 * hi);
#pragma unroll
                for (int i = 0; i < 4; ++i) { st.o[0][4 * g + i] *= fv[i]; st.o[1][4 * g + i] *= fv[i]; } }
        }
    }
    __builtin_amdgcn_sched_barrier(0);
    VFrags vf; vfrags(vf, vp);
    float sacc = 0.f, sacc2 = 0.f;
#pragma unroll
    for (int r = 0; r < 16; ++r) { p0[r] = __builtin_amdgcn_exp2f(p0[r]); p1[r] = __builtin_amdgcn_exp2f(p1[r]); sacc = fadd_s(sacc, p0[r]); sacc2 = fadd_s(sacc2, p1[r]); }
    st.l = fadd_s(st.l, fadd_s(sacc, sacc2));
    const u32x4 pw0 = ATT_PACK4(p0, 0, cvtpk), pw1 = ATT_PACK4(p0, 8, cvtpk), pw2 = ATT_PACK4(p1, 0, cvtpk), pw3 = ATT_PACK4(p1, 8, cvtpk);
    __builtin_amdgcn_sched_barrier(0);
    if (LEVEL == 3) { asm volatile("" :: "v"(pw0), "v"(pw1), "v"(pw2), "v"(pw3), "v"(vf.lo[0]), "v"(vf.hh[7])); return; }
    pv(st.o, vf, pw0, pw1, pw2, pw3);
}

struct SbTile { f32x16 z0, z1; u32x4 lw0, lw1, lw2, lw3; };
template <bool NEED_SUM>
__device__ __forceinline__ void sb_part1(SbTile& t, float& tsum, lds_cptr kslot, const bf16x8 (&qr)[4], bool masked, int qlim, int r32, int hi) {
    bf16x8 kf[8]; kfrags(kf, kslot, r32, hi);
    t.z0 = (f32x16){}; t.z1 = (f32x16){};
#pragma unroll
    for (int d0 = 0; d0 < 4; ++d0) {
        t.z0 = __builtin_amdgcn_mfma_f32_32x32x16_bf16(kf[2 * d0], qr[d0], t.z0, 0, 0, 0);
        t.z1 = __builtin_amdgcn_mfma_f32_32x32x16_bf16(kf[2 * d0 + 1], qr[d0], t.z1, 0, 0, 0);
    }
    __builtin_amdgcn_sched_barrier(0);
    f32x16 l0, l1;
#pragma unroll
    for (int r = 0; r < 16; ++r) {
        const float a0 = t.z0[r], a1 = t.z1[r];
        l0[r] = fmaxf(a0, 0.f) + __builtin_amdgcn_logf(1.0f + __builtin_amdgcn_exp2f(-__builtin_fabsf(a0)));
        l1[r] = fmaxf(a1, 0.f) + __builtin_amdgcn_logf(1.0f + __builtin_amdgcn_exp2f(-__builtin_fabsf(a1)));
    }
    if (masked) {
        asm volatile("; masked tile" ::: "memory");
#pragma unroll
        for (int r = 0; r < 16; ++r) { const int kv = crow(r, hi); if (kv >= qlim) l0[r] = 0.f; if (kv + 32 >= qlim) l1[r] = 0.f; }
    }
    if (NEED_SUM) {
        float s = 0.f, s2 = 0.f;
#pragma unroll
        for (int r = 0; r < 16; ++r) { s = fadd_s(s, l0[r]); s2 = fadd_s(s2, l1[r]); }
        tsum = -swap_sum(fadd_s(s, s2));
    }
    t.lw0 = ATT_PACK4(l0, 0, cvtpk_h); t.lw1 = ATT_PACK4(l0, 8, cvtpk_h); t.lw2 = ATT_PACK4(l1, 0, cvtpk_h); t.lw3 = ATT_PACK4(l1, 8, cvtpk_h);
}
__device__ __forceinline__ float sb_part2(f32x16 (&o)[2], const SbTile& t, float R, lds_cptr vp, const f16x8& T00, const f16x8& T01, bool masked, int qlim, int r32, int hi) {
    VFrags vf; vfrags(vf, vp);
    f32x16 w0, w1;
#pragma unroll
    for (int r = 0; r < 16; ++r) { w0[r] = R; w1[r] = R; }
    const f16x8 ones = {(_Float16)-1.0f, (_Float16)-1.0f, (_Float16)-1.0f, (_Float16)-1.0f, (_Float16)-1.0f, (_Float16)-1.0f, (_Float16)-1.0f, (_Float16)-1.0f};
    w0 = __builtin_amdgcn_mfma_f32_32x32x16_f16(T00, __builtin_bit_cast(f16x8, t.lw0), w0, 0, 0, 0);
    w1 = __builtin_amdgcn_mfma_f32_32x32x16_f16(T00, __builtin_bit_cast(f16x8, t.lw2), w1, 0, 0, 0);
    w0 = __builtin_amdgcn_mfma_f32_32x32x16_f16(T01, __builtin_bit_cast(f16x8, t.lw1), w0, 0, 0, 0);
    w1 = __builtin_amdgcn_mfma_f32_32x32x16_f16(T01, __builtin_bit_cast(f16x8, t.lw3), w1, 0, 0, 0);
    w0 = __builtin_amdgcn_mfma_f32_32x32x16_f16(ones, __builtin_bit_cast(f16x8, t.lw2), w0, 0, 0, 0);
    w0 = __builtin_amdgcn_mfma_f32_32x32x16_f16(ones, __builtin_bit_cast(f16x8, t.lw3), w0, 0, 0, 0);
    __builtin_amdgcn_sched_barrier(0);
    const float rnext = __shfl(w0[0], r32);
    f32x16 a0, a1;
#pragma unroll
    for (int r = 0; r < 16; ++r) { a0[r] = __builtin_amdgcn_exp2f(t.z0[r] + w0[r]); a1[r] = __builtin_amdgcn_exp2f(t.z1[r] + w1[r]); }
    if (masked) {
        asm volatile("; masked tile" ::: "memory");
#pragma unroll
        for (int r = 0; r < 16; ++r) { const int kv = crow(r, hi); if (kv >= qlim) a0[r] = 0.f; if (kv + 32 >= qlim) a1[r] = 0.f; }
    }
    const u32x4 pw0 = ATT_PACK4(a0, 0, cvtpk), pw1 = ATT_PACK4(a0, 8, cvtpk), pw2 = ATT_PACK4(a1, 0, cvtpk), pw3 = ATT_PACK4(a1, 8, cvtpk);
    __builtin_amdgcn_sched_barrier(0);
    pv(o, vf, pw0, pw1, pw2, pw3);
    return rnext;
}
__device__ __forceinline__ void make_tri(f16x8& T00, f16x8& T01, int r32, int hi) {
#pragma unroll
    for (int j = 0; j < 8; ++j) { const int kin = 8 * (j >> 2) + 4 * hi + (j & 3);
        T00[j] = (kin >= r32) ? (_Float16)-1.0f : (_Float16)0.0f; T01[j] = (16 + kin >= r32) ? (_Float16)-1.0f : (_Float16)0.0f; }
}

__device__ __forceinline__ float gate8(const f32x4& x0, const f32x4& x1, const float (&gn)[8], const u32x4& zw, bf16* orow) {
    const float zz[8] = {bflo(zw.x), bfhi(zw.x), bflo(zw.y), bfhi(zw.y), bflo(zw.z), bfhi(zw.z), bflo(zw.w), bfhi(zw.w)};
    const float xs[8] = {x0[0], x0[1], x0[2], x0[3], x1[0], x1[1], x1[2], x1[3]};
    float r[8], ssq = 0.f;
#pragma unroll
    for (int i = 0; i < 8; ++i) { ssq += xs[i] * xs[i]; r[i] = xs[i] * gn[i] * (zz[i] / (1.0f + __expf(-zz[i]))); }
    u32x4 w; w.x = cvtpk(r[0], r[1]); w.y = cvtpk(r[2], r[3]); w.z = cvtpk(r[4], r[5]); w.w = cvtpk(r[6], r[7]);
    *(u32x4*)orow = w;
    return ssq;
}

struct EpiPre { u32x4 z[4]; f32x4 g0, g1; };
template <int TYPE>
__device__ __forceinline__ void epi_preload(EpiPre& e, const Args& a, int l, int h, size_t rowq, int col, int lane) {
    const int ch = lane & 7;
    const float* gp = (TYPE == 0 ? a.gn_a : a.gn_b) + (size_t)l * W + h * HD + ch * 8;
    e.g0 = *(const f32x4*)gp; e.g1 = *(const f32x4*)(gp + 4);
#pragma unroll
    for (int i = 0; i < 4; ++i) e.z[i] = *(const u32x4*)((const bf16*)(a.ws + WS_Z) + (rowq + i * 8 + (lane >> 3)) * D + col + ch * 8);
}
template <int TYPE>
__device__ __forceinline__ void prompt_epilogue(const Args& a, int l, int h, size_t rowq  , int col, FoxState& st, const EpiPre& pre, LAS float* wsf, LAS float* stg, int lane, int r32, int hi) {
    if (TYPE == 0) {
        const float inv = 1.0f / swap_sum(st.l);
        if (hi == 0) wsf[r32] = inv;
        ATT_LDS_WAIT();
#pragma unroll
        for (int g = 0; g < 4; ++g) { const f32x4 f = *(const LAS f32x4*)(wsf + 8 * g + 4 * hi);
#pragma unroll
            for (int i = 0; i < 4; ++i) { st.o[0][4 * g + i] *= f[i]; st.o[1][4 * g + i] *= f[i]; } }
    }
#pragma unroll
    for (int r = 0; r < 16; ++r) { stg[crow(r, hi) * 64 + r32] = st.o[0][r]; stg[crow(r, hi) * 64 + 32 + r32] = st.o[1][r]; }
    ATT_LDS_WAIT();
    const int ch = lane & 7;
    const float gn[8] = {pre.g0[0], pre.g0[1], pre.g0[2], pre.g0[3], pre.g1[0], pre.g1[1], pre.g1[2], pre.g1[3]};
#pragma unroll
    for (int i = 0; i < 4; ++i) {
        const int row = i * 8 + (lane >> 3); const size_t grow = rowq + row;
        const f32x4 x0 = *(const LAS f32x4*)(stg + row * 64 + ch * 8), x1 = *(const LAS f32x4*)(stg + row * 64 + ch * 8 + 4);
        float ssq = gate8(x0, x1, gn, pre.z[i], (bf16*)(a.ws + WS_HN) + grow * D + col + ch * 8);
        ssq = sum8_dpp(ssq);
        if (ch == 0) ((float*)(a.ws + WS_SSQ))[grow * 16 + TYPE * 8 + h] = ssq;
    }
}

struct ConvRegs { u32x4 k[4], v[4]; };
__device__ __forceinline__ void conv_load(ConvRegs& c, const Args& a, size_t rowq, int col, int lane) {
#pragma unroll
    for (int i = 0; i < 4; ++i) { const size_t grow = rowq + i * 8 + (lane >> 3);
        c.k[i] = *(const u32x4*)((const bf16*)(a.ws + WS_K) + grow * D + col + (lane & 7) * 8); c.v[i] = *(const u32x4*)((const bf16*)(a.ws + WS_V) + grow * D + col + (lane & 7) * 8); }
}
template <int TYPE>
__device__ __forceinline__ void conv_store(const ConvRegs& c, const Args& a, int l, int h, size_t rowq, int lane) {
#pragma unroll
    for (int i = 0; i < 4; ++i) { const size_t grow = rowq + i * 8 + (lane >> 3);
        float* ko = a.out + (TYPE == 0 ? O_FKP : O_SKP) + ((size_t)l * MP + grow) * W + h * HD + (lane & 7) * 8;
        float* vo = a.out + (TYPE == 0 ? O_FVP : O_SVP) + ((size_t)l * MP + grow) * W + h * HD + (lane & 7) * 8;
        const u32x4 kw = c.k[i], vw = c.v[i];
        __builtin_nontemporal_store((f32x4){bflo(kw.x), bfhi(kw.x), bflo(kw.y), bfhi(kw.y)}, (f32x4*)ko); __builtin_nontemporal_store((f32x4){bflo(kw.z), bfhi(kw.z), bflo(kw.w), bfhi(kw.w)}, (f32x4*)(ko + 4));
        __builtin_nontemporal_store((f32x4){bflo(vw.x), bfhi(vw.x), bflo(vw.y), bfhi(vw.y)}, (f32x4*)vo); __builtin_nontemporal_store((f32x4){bflo(vw.z), bfhi(vw.z), bflo(vw.w), bfhi(vw.w)}, (f32x4*)(vo + 4)); }
}

struct PairP { u32x4 w[8]; };
__device__ __forceinline__ bool fox_pair_qs(FoxState& st, PairP& pp, lds_cptr kslotB, const bf16x8 (&qr)[4], const LAS u32x2* augB  , bool careful, int r32, int hi, LAS float* wsf) {
    bf16x8 kfA[8], kfB[8]; kfrags(kfA, kslotB + 8192, r32, hi); kfrags(kfB, kslotB, r32, hi);
    const u32x2 t0 = augB[64], t1 = augB[96], t2 = augB[0], t3 = augB[32];
    const f32x16 zz = {};
    f32x16 a0, a1, b0, b1;
    a0 = __builtin_amdgcn_mfma_f32_32x32x16_bf16(__builtin_bit_cast(bf16x8, (u32x4){t0.x, t0.y, 0xBF80BF80u, 0u}), st.mq, zz, 0, 0, 0);
    a1 = __builtin_amdgcn_mfma_f32_32x32x16_bf16(__builtin_bit_cast(bf16x8, (u32x4){t1.x, t1.y, 0xBF80BF80u, 0u}), st.mq, zz, 0, 0, 0);
    b0 = __builtin_amdgcn_mfma_f32_32x32x16_bf16(__builtin_bit_cast(bf16x8, (u32x4){t2.x, t2.y, 0xBF80BF80u, 0u}), st.mq, zz, 0, 0, 0);
    b1 = __builtin_amdgcn_mfma_f32_32x32x16_bf16(__builtin_bit_cast(bf16x8, (u32x4){t3.x, t3.y, 0xBF80BF80u, 0u}), st.mq, zz, 0, 0, 0);
#pragma unroll
    for (int d0 = 0; d0 < 4; ++d0) {
        a0 = __builtin_amdgcn_mfma_f32_32x32x16_bf16(kfA[2 * d0], qr[d0], a0, 0, 0, 0); a1 = __builtin_amdgcn_mfma_f32_32x32x16_bf16(kfA[2 * d0 + 1], qr[d0], a1, 0, 0, 0);
        b0 = __builtin_amdgcn_mfma_f32_32x32x16_bf16(kfB[2 * d0], qr[d0], b0, 0, 0, 0); b1 = __builtin_amdgcn_mfma_f32_32x32x16_bf16(kfB[2 * d0 + 1], qr[d0], b1, 0, 0, 0);
    }
    if (careful) {
        asm volatile("; careful pass: move the reference" ::: "memory");
        float rm = max3f(a0[0], a1[0], b0[0]), rm2 = max3f(b1[0], a0[1], a1[1]);
        rm = max3f(rm, b0[1], b1[1]);
#pragma unroll
        for (int r = 2; r < 16; ++r) { rm = max3f(rm, a0[r], a1[r]); rm2 = max3f(rm2, b0[r], b1[r]); }
        rm = swap_max(max3f(rm, rm2, rm2));
        const float dl = fmaxf(rm, 0.f);
        st.m += dl; st.mq = make_mq(st.m, hi);
#pragma unroll
        for (int r = 0; r < 16; ++r) { a0[r] -= dl; a1[r] -= dl; b0[r] -= dl; b1[r] -= dl; }
        const float f = __builtin_amdgcn_exp2f(-dl);
        st.l *= f;
        if (hi == 0) wsf[r32] = f;
        ATT_LDS_WAIT();
#pragma unroll
        for (int g = 0; g < 4; ++g) { const f32x4 fv = *(const LAS f32x4*)(wsf + 8 * g + 4 * hi);
#pragma unroll
            for (int i = 0; i < 4; ++i) { st.o[0][4 * g + i] *= fv[i]; st.o[1][4 * g + i] *= fv[i]; } }
    }
    float sacc = 0.f, sacc2 = 0.f;
#pragma unroll
    for (int r = 0; r < 16; ++r) { a0[r] = __builtin_amdgcn_exp2f(a0[r]); a1[r] = __builtin_amdgcn_exp2f(a1[r]); sacc = fadd_s(sacc, a0[r]); sacc2 = fadd_s(sacc2, a1[r]); }
    pp.w[0] = ATT_PACK4(a0, 0, cvtpk); pp.w[1] = ATT_PACK4(a0, 8, cvtpk); pp.w[2] = ATT_PACK4(a1, 0, cvtpk); pp.w[3] = ATT_PACK4(a1, 8, cvtpk);
#pragma unroll
    for (int r = 0; r < 16; ++r) { b0[r] = __builtin_amdgcn_exp2f(b0[r]); b1[r] = __builtin_amdgcn_exp2f(b1[r]); sacc = fadd_s(sacc, b0[r]); sacc2 = fadd_s(sacc2, b1[r]); }
    pp.w[4] = ATT_PACK4(b0, 0, cvtpk); pp.w[5] = ATT_PACK4(b0, 8, cvtpk); pp.w[6] = ATT_PACK4(b1, 0, cvtpk); pp.w[7] = ATT_PACK4(b1, 8, cvtpk);
    const float ts = fadd_s(sacc, sacc2);
    if (!careful && __any(!(ts < FOX_BIG))) return false;
    st.l = fadd_s(st.l, ts);
    return true;
}
__device__ __forceinline__ void fox_pair_pv(FoxState& st, const PairP& pp, lds_cptr vpB) {
    { VFrags vf; vfrags(vf, vpB + 8192); pv(st.o, vf, pp.w[0], pp.w[1], pp.w[2], pp.w[3]); }
    { VFrags vf; vfrags(vf, vpB); pv(st.o, vf, pp.w[4], pp.w[5], pp.w[6], pp.w[7]); }
}

constexpr int F_K = 0, F_V = 49152, F_CK = 98304, F_WSF = 106496, F_AUG = 108544;
__device__ __forceinline__ void prompt_unit_fox(const Args& a, int l, int b, int h, int qb, LAS unsigned char* lds) {
    int tid_ = threadIdx.x; asm volatile("" : "+v"(tid_));
    const int tid = tid_, lane = tid & 63, r32 = lane & 31, hi = lane >> 5, wid = __builtin_amdgcn_readfirstlane(tid >> 6);
    const int q0 = qb * 256, NP = (q0 + 256) / 128, jd = q0 / 64 + (wid >> 1), jpd = jd >> 1;
    const bool lateB = wid >= 4;
    const int col = h * HD;
    const size_t rowb = (size_t)b * T;
    const bf16* Kh = (const bf16*)(a.ws + WS_K) + rowb * D + col; const bf16* Vh = (const bf16*)(a.ws + WS_V) + rowb * D + col;
    const unsigned lds0 = (unsigned)(uintptr_t)lds;
    const bf16* ksrc = Kh + (size_t)lane * D + wid * 8;
    const bf16* vsrc = Vh + (size_t)(16 * (wid & 3) + (lane >> 2)) * D + (wid >> 2) * 32 + (lane & 3) * 8;
#define ATT_DMA2(jp, slot) do { \
        glds16(ksrc + (size_t)(jp) * 128 * D, (unsigned)__builtin_amdgcn_readfirstlane(lds0 + F_K + (slot) * 16384 + wid * 1024)); \
        glds16(ksrc + (size_t)(jp) * 128 * D + 64 * D, (unsigned)__builtin_amdgcn_readfirstlane(lds0 + F_K + (slot) * 16384 + 8192 + wid * 1024)); \
        glds16(vsrc + (size_t)(jp) * 128 * D, (unsigned)__builtin_amdgcn_readfirstlane(lds0 + F_V + (slot) * 16384 + wid * 1024)); \
        glds16(vsrc + (size_t)(jp) * 128 * D + 64 * D, (unsigned)__builtin_amdgcn_readfirstlane(lds0 + F_V + (slot) * 16384 + 8192 + wid * 1024)); } while (0)
    ATT_DMA2(NP - 1, 0);
    { const int idx = tid * 4; if (idx < q0 + 256) { const f32x4 c = *(const f32x4*)((const float*)(a.ws + WS_CKP) + (size_t)(b * 8 + h) * T + idx); *(LAS f32x4*)(lds + F_CK + idx * 4) = c;
#pragma unroll
        for (int e = 0; e < 4; ++e) { const float h1 = bf_hi_part(c[e]), r1 = c[e] - h1, h2 = bf_hi_part(r1), r2 = r1 - h2; ((LAS u32x2*)(lds + F_AUG))[idx + e] = (u32x2){cvtpk(h1, h2), cvtpk(r2, -1.0f)}; } } }
    bf16x8 qr[4];
    { const bf16* Qw = (const bf16*)(a.ws + WS_Q) + (rowb + q0 + wid * 32 + r32) * D + col;
#pragma unroll
      for (int d0 = 0; d0 < 4; ++d0) qr[d0] = *(const bf16x8*)(Qw + d0 * 16 + hi * 8); }
    const lds_cptr vp0 = (lds_cptr)lds + F_V + ((lane >> 4) & 1) * 32 + (lane & 3) * 8 + (4 * hi + ((lane & 15) >> 2)) * 64;
    const int ql = 32 * (wid & 1) + r32, qlim = ql + 1;
    LAS float* wsf = (LAS float*)(lds + F_WSF) + wid * 64;
    FoxState st; st.m = 0.f; st.l = 0.f; st.mq = (bf16x8){}; st.o[0] = (f32x16){}; st.o[1] = (f32x16){};
    PairP pp; bool pending = false;
#pragma unroll
    for (int i = 0; i < 8; ++i) pp.w[i] = (u32x4){0u, 0u, 0u, 0u};
    { ConvRegs cv; conv_load(cv, a, rowb + q0 + wid * 32, col, lane); conv_store<0>(cv, a, l, h, rowb + q0 + wid * 32, lane); }
    int slot = 0, pslot = 0;
    for (int jp = NP - 1; jp >= 0; --jp) {
        ATT_WAIT_BAR();
        if (jp >= 1) ATT_DMA2(jp - 1, slot == 2 ? 0 : slot + 1);
        const lds_cptr kslot = (lds_cptr)lds + F_K + slot * 16384; const lds_cptr vp = vp0 + slot * 16384;
        const LAS float* ck0 = (const LAS float*)(lds + F_CK) + (2 * jp) * 64 + 4 * hi;
        if (pending) { fox_pair_pv(st, pp, vp0 + pslot * 16384); pending = false; }
        if (jp < jpd) {
            bool careful = false;
#pragma unroll 1
            for (int pass = 0; pass < 2; ++pass) { if (fox_pair_qs(st, pp, kslot, qr, (const LAS u32x2*)(lds + F_AUG) + (2 * jp) * 64 + r32, careful, r32, hi, wsf)) break; careful = true; }
            if (lateB) { pending = true; pslot = slot; } else fox_pair_pv(st, pp, vp);
        } else if (jp == jpd) {
            if (jd & 1) { fox_tile(st, kslot + 8192, vp + 8192, qr, ck0 + 64, true, true, qlim, r32, hi, wsf); fox_tile(st, kslot, vp, qr, ck0, false, false, qlim, r32, hi, wsf); }
            else fox_tile(st, kslot, vp, qr, ck0, true, true, qlim, r32, hi, wsf);
        }
        slot = (slot == 2) ? 0 : slot + 1;
    }
#undef ATT_DMA2
    if (pending) fox_pair_pv(st, pp, vp0 + pslot * 16384);
    EpiPre pre; epi_preload<0>(pre, a, l, h, rowb + q0 + wid * 32, col, lane);
    ATT_WAIT_BAR();
    prompt_epilogue<0>(a, l, h, rowb + q0 + wid * 32, col, st, pre, wsf, (LAS float*)lds + wid * 2048, lane, r32, hi);
}

template <int TYPE, int SKEL = 0>
__device__ __forceinline__ void prompt_unit(const Args& a, int l, int b, int h, int qb, LAS unsigned char* lds) {
    int tid_ = threadIdx.x; asm volatile("" : "+v"(tid_));
    const int tid = tid_, lane = tid & 63, r32 = lane & 31, hi = lane >> 5, wid = __builtin_amdgcn_readfirstlane(tid >> 6);
    f16x8 T00, T01; if (TYPE == 1) make_tri(T00, T01, r32, hi);
    const int q0 = qb * 256, NT = (q0 + 256) / 64, jd = q0 / 64 + (wid >> 1);
    const int col = TYPE * W + h * HD;
    const size_t rowb = (size_t)b * T;
    const bf16* Kh = (const bf16*)(a.ws + WS_K) + rowb * D + col; const bf16* Vh = (const bf16*)(a.ws + WS_V) + rowb * D + col;
    const unsigned lds0 = (unsigned)(uintptr_t)lds;
    const bf16* ksrc = Kh + (size_t)lane * D + wid * 8;
    const bf16* vsrc = Vh + (size_t)(16 * (wid & 3) + (lane >> 2)) * D + (wid >> 2) * 32 + (lane & 3) * 8;
#define ATT_DMA(jt, slot) do { glds16(ksrc + (size_t)(jt) * 64 * D, (unsigned)__builtin_amdgcn_readfirstlane(lds0 + A_K + (slot) * 8192 + wid * 1024)); \
                               glds16(vsrc + (size_t)(jt) * 64 * D, (unsigned)__builtin_amdgcn_readfirstlane(lds0 + A_V + (slot) * 8192 + wid * 1024)); } while (0)
    ATT_DMA(NT - 1, 0); ATT_DMA(NT - 2, 1); ATT_DMA(NT - 3, 2);
    if (TYPE == 0) { const int idx = tid * 4; if (idx < q0 + 256) *(LAS f32x4*)(lds + A_CK + idx * 4) = *(const f32x4*)((const float*)(a.ws + WS_CKP) + (size_t)(b * 8 + h) * T + idx); }
    bf16x8 qr[4];
    { const bf16* Qw = (const bf16*)(a.ws + WS_Q) + (rowb + q0 + wid * 32 + r32) * D + col;
#pragma unroll
      for (int d0 = 0; d0 < 4; ++d0) qr[d0] = *(const bf16x8*)(Qw + d0 * 16 + hi * 8); }
    const lds_cptr vp0 = (lds_cptr)lds + A_V + ((lane >> 4) & 1) * 32 + (lane & 3) * 8 + (4 * hi + ((lane & 15) >> 2)) * 64;
    const int ql = 32 * (wid & 1) + r32, qlim = (TYPE == 0) ? ql + 1 : ql;
    LAS float* wsf = (LAS float*)(lds + A_WSF) + wid * 64;
    LAS unsigned* flags = (LAS unsigned*)(lds + A_FLAG);
    FoxState st; st.m = 0.f; st.l = 0.f; st.mq = (bf16x8){}; st.o[0] = (f32x16){}; st.o[1] = (f32x16){};
    float R = 0.f; bool done = false;
    { ConvRegs cv; conv_load(cv, a, rowb + q0 + wid * 32, col, lane); conv_store<TYPE>(cv, a, l, h, rowb + q0 + wid * 32, lane); }
    int it = 0;
    for (int jt = NT - 1; jt >= 0; --jt, ++it) {
        if (jt >= 2) ATT_WAIT_BAR_N(4); else if (jt == 1) ATT_WAIT_BAR_N(2); else ATT_WAIT_BAR_N(0);
        if (TYPE == 1 && it > 0) {
            const u32x4 f0 = *(const LAS u32x4*)(flags + ((it - 1) & 1) * 8), f1 = *(const LAS u32x4*)(flags + ((it - 1) & 1) * 8 + 4);
            if ((f0.x & f0.y & f0.z & f0.w & f1.x & f1.y & f1.z & f1.w) != 0u) break;
        }
        if (jt >= 3) ATT_DMA(jt - 3, (it + 3) & 3);
        const int slot = it & 3;
        const lds_cptr kslot = (lds_cptr)lds + A_K + slot * 8192; const lds_cptr vp = vp0 + slot * 8192;
        if (SKEL != 1 && jt <= jd && !done) {
            if (TYPE == 0) {
                const LAS float* ckt = (const LAS float*)(lds + A_CK) + jt * 64 + 4 * hi;
                fox_tile<SKEL == 0 ? 9 : SKEL>(st, kslot, vp, qr, ckt, jt == jd, jt == jd, qlim, r32, hi, wsf);
            } else {
                SbTile tl; float tsum;
                sb_part1<false>(tl, tsum, kslot, qr, jt == jd, qlim, r32, hi); R = sb_part2(st.o, tl, R, vp, T00, T01, jt == jd, qlim, r32, hi);
                done = __all(R < R_DONE);
            }
        }
        if (TYPE == 1 && lane == 0) flags[(it & 1) * 8 + wid] = done ? 1u : 0u;
    }
#undef ATT_DMA
    EpiPre pre; epi_preload<TYPE>(pre, a, l, h, rowb + q0 + wid * 32, col, lane);
    ATT_WAIT_BAR();
    if (SKEL) { asm volatile("" :: "v"(st.o[0]), "v"(st.o[1]), "v"(st.l)); return; }
    prompt_epilogue<TYPE>(a, l, h, rowb + q0 + wid * 32, col, st, pre, wsf, (LAS float*)(lds + A_STG) + wid * 2048, lane, r32, hi);
}

constexpr int B_K = 0, B_V = 65536, B_WSF = 132096, B_FLAG = 134144, B_STG = 0;
__device__ __forceinline__ void prompt_unit_sb(const Args& a, int l, int b, int h, int qb, LAS unsigned char* lds) {
    int tid_ = threadIdx.x; asm volatile("" : "+v"(tid_));
    const int tid = tid_, lane = tid & 63, r32 = lane & 31, hi = lane >> 5, wid = __builtin_amdgcn_readfirstlane(tid >> 6);
    f16x8 T00, T01; make_tri(T00, T01, r32, hi);
    const int q0 = qb * 256, jb = q0 / 64, jd = jb + (wid >> 1);
    const int col = W + h * HD;
    const size_t rowb = (size_t)b * T;
    const bf16* Kh = (const bf16*)(a.ws + WS_K) + rowb * D + col; const bf16* Vh = (const bf16*)(a.ws + WS_V) + rowb * D + col;
    const unsigned lds0 = (unsigned)(uintptr_t)lds;
    const bf16* ksrc = Kh + (size_t)lane * D + wid * 8;
    const bf16* vsrc = Vh + (size_t)(16 * (wid & 3) + (lane >> 2)) * D + (wid >> 2) * 32 + (lane & 3) * 8;
#define ATT_DMA(jt) do { const int s_ = (jt) & 7; glds16(ksrc + (size_t)(jt) * 64 * D, (unsigned)__builtin_amdgcn_readfirstlane(lds0 + B_K + s_ * 8192 + wid * 1024)); \
                         glds16(vsrc + (size_t)(jt) * 64 * D, (unsigned)__builtin_amdgcn_readfirstlane(lds0 + B_V + s_ * 8192 + wid * 1024)); } while (0)
    ATT_DMA(jb + 3); ATT_DMA(jb + 2); ATT_DMA(jb + 1); ATT_DMA(jb);
    if (jb >= 4) { ATT_DMA(jb - 1); ATT_DMA(jb - 2); ATT_DMA(jb - 3); }
    bf16x8 qr[4];
    { const bf16* Qw = (const bf16*)(a.ws + WS_Q) + (rowb + q0 + wid * 32 + r32) * D + col;
#pragma unroll
      for (int d0 = 0; d0 < 4; ++d0) qr[d0] = *(const bf16x8*)(Qw + d0 * 16 + hi * 8); }
    const lds_cptr vp0 = (lds_cptr)lds + B_V + ((lane >> 4) & 1) * 32 + (lane & 3) * 8 + (4 * hi + ((lane & 15) >> 2)) * 64;
    const int qlim = 32 * (wid & 1) + r32;
    LAS float* wsf = (LAS float*)(lds + B_WSF) + wid * 64;
    LAS unsigned* flags = (LAS unsigned*)(lds + B_FLAG);
    FoxState st; st.m = 0.f; st.l = 0.f; st.mq = (bf16x8){}; st.o[0] = (f32x16){}; st.o[1] = (f32x16){};
    float R = 0.f; bool done = false;
    { ConvRegs cv; conv_load(cv, a, rowb + q0 + wid * 32, col, lane); conv_store<1>(cv, a, l, h, rowb + q0 + wid * 32, lane); }
    for (int it = 0; ; ++it) {
        const int need = jb - it;
        if (need >= 3) ATT_WAIT_BAR_N(6); else if (need == 2) ATT_WAIT_BAR_N(4); else if (need == 1) ATT_WAIT_BAR_N(2); else ATT_WAIT_BAR_N(0);
        if (it > 0) {
            const u32x4 f0 = *(const LAS u32x4*)(flags + ((it - 1) & 1) * 8), f1 = *(const LAS u32x4*)(flags + ((it - 1) & 1) * 8 + 4);
            if ((f0.x & f0.y & f0.z & f0.w & f1.x & f1.y & f1.z & f1.w) != 0u) break;
        }
        if (need >= 4) ATT_DMA(need - 4);
        const int jt = jd - it;
        if (jt >= 0 && !done) {
            const int slot = jt & 7;
            const lds_cptr kslot = (lds_cptr)lds + B_K + slot * 8192; const lds_cptr vp = vp0 + slot * 8192;
            SbTile tl; float tsum;
            sb_part1<false>(tl, tsum, kslot, qr, it == 0, qlim, r32, hi); R = sb_part2(st.o, tl, R, vp, T00, T01, it == 0, qlim, r32, hi);
            done = __all(R < R_DONE);
        }
        if (jt <= 0) done = true;
        if (lane == 0) flags[(it & 1) * 8 + wid] = done ? 1u : 0u;
    }
#undef ATT_DMA
    EpiPre pre; epi_preload<1>(pre, a, l, h, rowb + q0 + wid * 32, col, lane);
    ATT_WAIT_BAR();
    prompt_epilogue<1>(a, l, h, rowb + q0 + wid * 32, col, st, pre, wsf, (LAS float*)(lds + B_STG) + wid * 2048, lane, r32, hi);
}

template <int TYPE>
__device__ __forceinline__ void sample_unit(const Args& a, int l, int b, int h, LAS unsigned char* lds) {
    int tid_ = threadIdx.x; asm volatile("" : "+v"(tid_));
    const int tid = tid_, lane = tid & 63, r32 = lane & 31, hi = lane >> 5, wid = __builtin_amdgcn_readfirstlane(tid >> 6);
    f16x8 T00, T01; if (TYPE == 1) make_tri(T00, T01, r32, hi);
    const int col = TYPE * W + h * HD;
    LAS unsigned char* kreg = lds + wid * 16384; LAS unsigned char* vreg = kreg + 8192;
    const float* kc = (TYPE == 0 ? a.c_fk : a.c_sk) + (((size_t)l * DB + b) * PAST) * W + h * HD;
    const float* vc = (TYPE == 0 ? a.c_fv : a.c_sv) + (((size_t)l * DB + b) * PAST) * W + h * HD;
    const float* kn = a.out + (TYPE == 0 ? O_FKS : O_SKS) + ((size_t)l * MS + b * DT) * W + h * HD;
    const float* vn = a.out + (TYPE == 0 ? O_FVS : O_SVS) + ((size_t)l * MS + b * DT) * W + h * HD;
    const float* ckb = (const float*)(a.ws + WS_CKS) + (size_t)(b * 8 + h) * SKV;
    bf16x8 qr[4];
    { const bf16* Qw = (const bf16*)(a.ws + WS_Q) + ((size_t)MP + b * DT + (r32 & 15)) * D + col;
#pragma unroll
      for (int d0 = 0; d0 < 4; ++d0) { qr[d0] = *(const bf16x8*)(Qw + d0 * 16 + hi * 8); if (r32 >= 16) qr[d0] = (bf16x8){}; } }
    const lds_cptr vp = (lds_cptr)vreg + ((lane >> 4) & 1) * 32 + (lane & 3) * 8 + (4 * hi + ((lane & 15) >> 2)) * 64;
    const int qlim_new = (TYPE == 0) ? (r32 < 16 ? r32 + 1 : 16) : (r32 < 16 ? r32 : 0);
    LAS float* wsf = (LAS float*)(lds + S_WSF) + wid * 64;
    LAS float* xT = (LAS float*)(lds + S_XT);
    FoxState st; st.m = 0.f; st.l = 0.f; st.mq = (bf16x8){}; st.o[0] = (f32x16){}; st.o[1] = (f32x16){};
    float Rround = 0.f; bool started = false;
#define ATT_STAGE(src, nrows, ISV) do { _Pragma("unroll") for (int hh_ = 0; hh_ < 2; ++hh_) { f32x4 t_[8]; \
        _Pragma("unroll") for (int i = 0; i < 8; ++i) { const int row = 32 * hh_ + 4 * i + (lane >> 4); t_[i] = (row < (nrows)) ? __builtin_nontemporal_load((const f32x4*)((src) + (size_t)row * W + 4 * (lane & 15))) : (f32x4){0.f, 0.f, 0.f, 0.f}; }   \
        _Pragma("unroll") for (int i = 0; i < 8; ++i) { const int row = 32 * hh_ + 4 * i + (lane >> 4), c4 = lane & 15; u32x2 w_; w_.x = cvtpk(t_[i][0], t_[i][1]); w_.y = cvtpk(t_[i][2], t_[i][3]); \
            if (ISV) *(LAS u32x2*)(vreg + (c4 >> 3) * 4096 + (row >> 4) * 1024 + (row & 15) * 64 + (c4 & 7) * 8) = w_; \
            else *(LAS u32x2*)(kreg + (c4 >> 1) * 1024 + row * 16 + (c4 & 1) * 8) = w_; } asm volatile("" ::: "memory"); } } while (0)
    for (int rnd = 0; rnd < 9; ++rnd) {
        const int gidx = rnd * 8 + 7 - wid; const bool valid = gidx <= 64, isnew = gidx == 0; const int ct = 64 - gidx;
        const float* ksrc = isnew ? kn : kc + (size_t)ct * 64 * W; const float* vsrc = isnew ? vn : vc + (size_t)ct * 64 * W;
        const int nrows = isnew ? DT : 64;
        if (TYPE == 0) {
            if (valid) {
                ATT_LDS_WAIT();
                ATT_STAGE(ksrc, nrows, false); ATT_STAGE(vsrc, nrows, true);
                ATT_LDS_WAIT();
                const float* ckt = ckb + (isnew ? PAST : ct * 64) + 4 * hi;
                fox_tile(st, (lds_cptr)kreg, vp, qr, ckt, isnew, !started, qlim_new, r32, hi, wsf);
                started = true;
            }
        } else {
            SbTile tl; float tsum = 0.f;
            if (valid) {
                ATT_LDS_WAIT();
                ATT_STAGE(ksrc, nrows, false); ATT_STAGE(vsrc, nrows, true);
                ATT_LDS_WAIT();
                sb_part1<true>(tl, tsum, (lds_cptr)kreg, qr, isnew, qlim_new, r32, hi);
            }
            if (hi == 0) xT[((rnd & 1) * 8 + wid) * 32 + r32] = tsum;
            ATT_WAIT_BAR();
            float Rin = Rround, Rall = Rround;
#pragma unroll
            for (int w2 = 7; w2 >= 0; --w2) { const float tv = xT[((rnd & 1) * 8 + w2) * 32 + r32]; if (w2 > wid) Rin += tv; Rall += tv; }
            if (valid) (void)sb_part2(st.o, tl, Rin, vp, T00, T01, isnew, qlim_new, r32, hi);
            Rround = Rall;
            if (__all(r32 >= 16 || Rround < R_DONE)) break;
        }
    }
#undef ATT_STAGE
    LAS float* ml = (LAS float*)(lds + S_ML);
    if (TYPE == 0) {
        const float lt = swap_sum(st.l);
        if (!started) st.m = NEG;
        if (hi == 0) { ml[(wid * 2 + 0) * 32 + r32] = st.m; ml[(wid * 2 + 1) * 32 + r32] = lt; }
        ATT_WAIT_BAR();
        float M = NEG;
#pragma unroll
        for (int w2 = 0; w2 < 8; ++w2) M = fmaxf(M, ml[(w2 * 2) * 32 + r32]);
        float Lt = 0.f;
#pragma unroll
        for (int w2 = 0; w2 < 8; ++w2) Lt += __builtin_amdgcn_exp2f(ml[(w2 * 2) * 32 + r32] - M) * ml[(w2 * 2 + 1) * 32 + r32];
        const float sc = __builtin_amdgcn_exp2f(st.m - M) / Lt;
        if (hi == 0) wsf[r32] = sc;
        ATT_LDS_WAIT();
#pragma unroll
        for (int g = 0; g < 4; ++g) { const f32x4 f = *(const LAS f32x4*)(wsf + 8 * g + 4 * hi);
#pragma unroll
            for (int i = 0; i < 4; ++i) { st.o[0][4 * g + i] *= f[i]; st.o[1][4 * g + i] *= f[i]; } }
    }
    LAS float* stg = (LAS float*)kreg;
    ATT_LDS_WAIT();
#pragma unroll
    for (int r = 0; r < 16; ++r) { stg[crow(r, hi) * 64 + r32] = st.o[0][r]; stg[crow(r, hi) * 64 + 32 + r32] = st.o[1][r]; }
    ATT_WAIT_BAR();
    {
        const int row = 2 * wid + hi, c2 = 2 * r32;
        float s0 = 0.f, s1 = 0.f;
#pragma unroll
        for (int w2 = 0; w2 < 8; ++w2) { const f32x2 v = *(const LAS f32x2*)(lds + w2 * 16384 + (row * 64 + c2) * 4); s0 += v[0]; s1 += v[1]; }
        const size_t grow = (size_t)MP + b * DT + row;
        const unsigned zw = *(const unsigned*)((const bf16*)(a.ws + WS_Z) + grow * D + col + c2);
        const float* gp = (TYPE == 0 ? a.gn_a : a.gn_b) + (size_t)l * W + h * HD + c2;
        const float z0 = bflo(zw), z1 = bfhi(zw);
        const float g0 = s0 * gp[0] * (z0 / (1.0f + __expf(-z0))), g1 = s1 * gp[1] * (z1 / (1.0f + __expf(-z1)));
        *(unsigned*)((bf16*)(a.ws + WS_HN) + grow * D + col + c2) = cvtpk(g0, g1);
        float ssq = s0 * s0 + s1 * s1;
#pragma unroll
        for (int o2 = 1; o2 < 32; o2 <<= 1) ssq += __shfl_xor(ssq, o2);
        if (r32 == 0) ((float*)(a.ws + WS_SSQ))[grow * 16 + TYPE * 8 + h] = ssq;
    }
}

__device__ __forceinline__ int next_unit(unsigned* ctr, LAS unsigned char* lds) {
    ATT_WAIT_BAR();
    if (threadIdx.x == 0) *(LAS unsigned*)(lds + A_UNIT) = __hip_atomic_fetch_add(ctr, 1u, __ATOMIC_RELAXED, __HIP_MEMORY_SCOPE_AGENT);
    ATT_WAIT_BAR();
    return (int)*(volatile LAS unsigned*)(lds + A_UNIT);
}
#define ATT_QUEUE(CTR, LIMIT, CALL) do { int u = next_unit((CTR), lds); int par_ = 0; \
        while (u < (LIMIT)) { unsigned nxt_ = 0u; if (threadIdx.x == 0) nxt_ = __hip_atomic_fetch_add((CTR), 1u, __ATOMIC_RELAXED, __HIP_MEMORY_SCOPE_AGENT); \
            CALL; \
            if (threadIdx.x == 0) *(LAS unsigned*)(lds + A_UNIT + 16 + 4 * par_) = nxt_; \
            ATT_WAIT_BAR();                                    \
            u = (int)*(volatile LAS unsigned*)(lds + A_UNIT + 16 + 4 * par_); par_ ^= 1; } } while (0)
__device__ __forceinline__ void phase_attention(const Args& a, int l, LAS unsigned char* lds, unsigned* qctr  ) {
    constexpr int NS = 2 * DB * H, NPU = 2 * NB * H * 8, EVERY = 15, MIXED = NS * (EVERY + 1);
    ATT_QUEUE(qctr, NS + NPU, {
        const int us = __builtin_amdgcn_readfirstlane(u);
        int sidx = -1; int pidx;
        if (us < MIXED) { const int blkq = us / (EVERY + 1); const int r = us - blkq * (EVERY + 1); if (r == 0) sidx = blkq; pidx = blkq * EVERY + r - 1; }
        else pidx = NS * EVERY + (us - MIXED);
        if (sidx >= 0) { if (sidx < DB * H) sample_unit<0>(a, l, sidx >> 3, sidx & 7, lds); else { const int v = sidx - DB * H; sample_unit<1>(a, l, v >> 3, v & 7, lds); } }
        else {
            int fidx = -1; int sb;
            if (pidx < 256 * 12) { const int g = pidx / 12; const int r = pidx - g * 12; if (r < 8) fidx = g * 8 + r; sb = g * 4 + r - 8; }
            else sb = 1024 + (pidx - 256 * 12);
            if (fidx >= 0) prompt_unit_fox(a, l, fidx >> 6, (fidx >> 3) & 7, 7 - (fidx & 7), lds);
            else prompt_unit_sb(a, l, (sb & 255) >> 3, sb & 7, 7 - (sb >> 8), lds);
        }
    });
}
}

__device__ __forceinline__ void phase_final(const Args& a, int gwave, int nwaves, int lane) {
    const bf16* xb = (const bf16*)(a.ws + WS_XP);
    f32x4 gg[4];
#pragma unroll
    for (int j = 0; j < 4; ++j) gg[j] = *(const f32x4*)(a.fin_g + 4 * lane + 256 * j);
    for (int pr = gwave; pr < MT / 2; pr += nwaves) {
        const int r0 = 2 * pr, r1 = r0 + 1;
        u32x2 a_[4], b_[4];
#pragma unroll
        for (int j = 0; j < 4; ++j) { a_[j] = *(const u32x2*)(xb + (size_t)r0 * D + 4 * lane + 256 * j); b_[j] = *(const u32x2*)(xb + (size_t)r1 * D + 4 * lane + 256 * j); }
        f32x4 v[4], w[4]; float sa = 0.f, sb = 0.f;
#pragma unroll
        for (int j = 0; j < 4; ++j) { v[j] = (f32x4){bflo(a_[j].x), bfhi(a_[j].x), bflo(a_[j].y), bfhi(a_[j].y)}; w[j] = (f32x4){bflo(b_[j].x), bfhi(b_[j].x), bflo(b_[j].y), bfhi(b_[j].y)};
            sa += (v[j].x * v[j].x + v[j].y * v[j].y) + (v[j].z * v[j].z + v[j].w * v[j].w); sb += (w[j].x * w[j].x + w[j].y * w[j].y) + (w[j].z * w[j].z + w[j].w * w[j].w); }
        sa = wave_sum(sa); sb = wave_sum(sb);
        const float ra = 1.0f / sqrtf(sa * (1.0f / D) + EPS), rb = 1.0f / sqrtf(sb * (1.0f / D) + EPS);
        float* d0 = (r0 < MP) ? a.out + O_YP + (size_t)r0 * D : a.out + O_YS + (size_t)(r0 - MP) * D;
        float* d1 = (r1 < MP) ? a.out + O_YP + (size_t)r1 * D : a.out + O_YS + (size_t)(r1 - MP) * D;
#pragma unroll
        for (int j = 0; j < 4; ++j) { __builtin_nontemporal_store(v[j] * ra * gg[j], (f32x4*)(d0 + 4 * lane + 256 * j)); __builtin_nontemporal_store(w[j] * rb * gg[j], (f32x4*)(d1 + 4 * lane + 256 * j)); }
    }
}

#define IN(k) (lo <= (k) && (k) < hi)
#define SEAM(k) do { if (IN(k) && IN((k) + 1)) xcd_barrier(bar); } while (0)
typedef const __attribute__((address_space(4))) Args* KArgs;
__device__ __forceinline__ Args load_args(KArgs k) { Args a; a.x_prompt = k->x_prompt; a.x_sample = k->x_sample; a.c_fk = k->c_fk; a.c_fv = k->c_fv; a.c_fl = k->c_fl; a.c_sk = k->c_sk; a.c_sv = k->c_sv;
    a.norm_g = k->norm_g; a.w_in = k->w_in; a.b_f = k->b_f; a.gn_a = k->gn_a; a.gn_b = k->gn_b; a.w_out = k->w_out; a.fin_g = k->fin_g; a.out = k->out; a.ws = k->ws; a.ph_lo = k->ph_lo; a.ph_hi = k->ph_hi; return a; }
#define FRESH_IDS() KArgs kp_ = kp0; asm volatile("" : "+s"(kp_)); const Args a = load_args(kp_); int tid = threadIdx.x; asm volatile("" : "+v"(tid)); const int lane = tid & 63, wave = __builtin_amdgcn_readfirstlane(tid >> 6); \
    const int G = gridDim.x, blk = blockIdx.x; const int gtid = blk * NTHR + tid, gthreads = G * NTHR, gwave = blk * 8 + wave, nwaves = G * 8; \
    (void)lane; (void)gtid; (void)gthreads; (void)gwave; (void)nwaves
template <int l> __device__ __forceinline__ void run_layer(KArgs kp0, LAS unsigned char* lds, const XcdBarrier& bar, int lo, int hi) {
    constexpr int pb = 1 + 4 * l;
        if (IN(pb)) { FRESH_IDS(); if (l == 0) { phase_prep(a, gtid, gthreads, lds, wave, gwave, nwaves, lane); phase_norm(a, 0, gwave, nwaves, lane); } else phase_stats1(a, gwave, nwaves, lane); }
        SEAM(pb);
        if (IN(pb + 1)) {
            FRESH_IDS();
            phase_cumsum(a, l, lds, blk, wave, lane);
            EpiIn E{l, (bf16*)(a.ws + WS_Q), (bf16*)(a.ws + WS_K), (bf16*)(a.ws + WS_V), (bf16*)(a.ws + WS_Z), a.out};
#if FAST_GEMM
            { EpiInS ES{l, (bf16*)(a.ws + WS_Q), (bf16*)(a.ws + WS_K), (bf16*)(a.ws + WS_V), (bf16*)(a.ws + WS_Z), a.out, (l == 1) ? (const float*)(a.ws + WS_RSTD) : nullptr};
              for (int su = blk; su < 4 * (NPROJ / 64); su += G) small_gemm<false>((const bf16*)(a.ws + (l == 0 ? WS_HN : WS_XP)) + (size_t)MP * D, (const bf16*)(a.ws + WS_WIN) + (size_t)l * NPROJ * D, NPROJ, ES, su); }
            { pg8::Gemm gm{(const bf16*)(a.ws + (l == 0 ? WS_HN : WS_XP)), (const bf16*)(a.ws + WS_WIN) + (size_t)l * NPROJ * D, MP, NPROJ, D}; pg8::StaticOrder S; S.init(MP, NPROJ, G, blk);
              EpiInProj EF{l, (bf16*)(a.ws + WS_Q), (bf16*)(a.ws + WS_K), (bf16*)(a.ws + WS_V), (bf16*)(a.ws + WS_Z), nullptr  , (l == 1) ? (const float*)(a.ws + WS_RSTD) : nullptr};
              pg8::gemm_phase<EpiInProj, pg8::StaticOrder, true, true>(lds, gm, S, EF);
              if (PROBE_DOUBLE == 2) pg8::gemm_phase<EpiInProj, pg8::StaticOrder, true, true>(lds, gm, S, EF);
              if (PROBE_DOUBLE == 11) { EpiInProj EF2 = EF; EF2.out = nullptr; pg8::gemm_phase<EpiInProj, pg8::StaticOrder, true, true>(lds, gm, S, EF2); } }
#else
            naive_gemm<false>(lds, (const bf16*)(a.ws + WS_HN), (const bf16*)(a.ws + WS_WIN) + (size_t)l * NPROJ * D, MT, NPROJ, D, E, blk, G);
#endif
        }
        SEAM(pb + 1);
#if FAST_ATTN
        if (IN(pb + 2)) { FRESH_IDS(); att::phase_attention(a, l, lds, (unsigned*)(a.ws + WS_CTL) + CW_QUEUE + l * 256);
}
#else
        if (IN(pb + 2)) { FRESH_IDS(); attn_sample_naive(a, l, gtid, gthreads); attn_prompt_naive(a, l, gtid, gthreads); }
#endif
        SEAM(pb + 2);
        if (IN(pb + 3)) {
            FRESH_IDS();
            EpiOut E{l, a.x_prompt, a.x_sample, (const float*)(a.ws + WS_SSQ), (float*)(a.ws + WS_XP)};
#if FAST_GEMM
            { EpiOutS ES{l, a.x_sample, (const float*)(a.ws + WS_SSQ), (float*)(a.ws + WS_XP)};
              for (int su = blk; su < 4 * (D / 64); su += G) small_gemm<true>((const bf16*)(a.ws + WS_HN) + (size_t)MP * D, (const bf16*)(a.ws + WS_WOUT) + (size_t)l * D * D, D, ES, su); }
            { pg8::Gemm gm{(const bf16*)(a.ws + WS_HN), (const bf16*)(a.ws + WS_WOUT) + (size_t)l * D * D, MP, D, D}; pg8::StaticOrder S; S.init(MP, D, G, blk);
              EpiOutProj EF{l, a.x_prompt, a.x_sample, (const float*)(a.ws + WS_SSQ), (float*)(a.ws + WS_XP), (LAS float*)(lds + TAB_OFF)};
              pg8::gemm_phase<EpiOutProj, pg8::StaticOrder, true, true>(lds, gm, S, EF);
              if (PROBE_DOUBLE == 9 && l == 0) pg8::gemm_phase<EpiOutProj, pg8::StaticOrder, true, true>(lds, gm, S, EF); }
#else
            naive_gemm<true>(lds, (const bf16*)(a.ws + WS_HN), (const bf16*)(a.ws + WS_WOUT) + (size_t)l * D * D, MT, D, D, E, blk, G);
#endif
        }
        SEAM(pb + 3);
    }
#undef IN
#undef SEAM

constexpr int N_PHASES = 10;
__global__ void __launch_bounds__(NTHR, 2) fwd(Args a_in) {
    extern __shared__ __attribute__((aligned(16))) unsigned char lds_raw[];
    LAS unsigned char* lds = (LAS unsigned char*)lds_raw;
    volatile LAS unsigned* MISC = (volatile LAS unsigned*)(lds + MISC_OFF);
    if (threadIdx.x < 32) MISC[threadIdx.x] = 0u;
    __syncthreads();
    const KArgs kp0 = (KArgs)__builtin_amdgcn_kernarg_segment_ptr();
    unsigned* ctl = (unsigned*)(a_in.ws + WS_CTL);
    const bool multi = (a_in.ph_hi - a_in.ph_lo) > 1;
    XcdBarrier bar; bar.bar = ctl + CW_BAR; bar.x = 0; bar.st = nullptr;
    if (multi) bar = xcd_barrier_post(ctl + CW_BAR, MISC + 8);
    const int lo = a_in.ph_lo, hi = a_in.ph_hi;
#define IN(k) (lo <= (k) && (k) < hi)
#define SEAM(k) do { if (IN(k) && IN((k) + 1)) xcd_barrier(bar); } while (0)
    run_layer<0>(kp0, lds, bar, lo, hi);
    run_layer<1>(kp0, lds, bar, lo, hi);
    if (IN(9)) { FRESH_IDS(); phase_final(a, gwave, nwaves, lane); if (PROBE_DOUBLE == 10) phase_final(a, gwave, nwaves, lane); }
#undef IN
#undef SEAM
}

#ifndef MK_ONE_LAUNCH
#define MK_ONE_LAUNCH 1
#endif
extern "C" void kernel_launch(void* const* d_in, const int* in_sizes, int n_in, void* d_out, int out_size, void* d_ws, size_t ws_size, hipStream_t stream) {
    static int grid = 0;
    if (grid == 0) {
        if (n_in != 14 || (size_t)out_size != O_END || ws_size < WS_END) { fprintf(stderr, "kernel_launch: unexpected shapes: n_in %d out %d (want %zu) ws %zu (want %zu)\n", n_in, out_size, (size_t)O_END, ws_size, (size_t)WS_END); grid = -1; return; }
        int dev = 0, cus = 0, per_cu = 0;
        if (hipGetDevice(&dev) != hipSuccess || hipDeviceGetAttribute(&cus, hipDeviceAttributeMultiprocessorCount, dev) != hipSuccess) { grid = -1; return; }
        if (hipFuncSetAttribute((const void*)fwd, hipFuncAttributeMaxDynamicSharedMemorySize, LDS_BYTES) != hipSuccess) { fprintf(stderr, "kernel_launch: hipFuncSetAttribute failed\n"); grid = -1; return; }
        if (hipOccupancyMaxActiveBlocksPerMultiprocessor(&per_cu, (const void*)fwd, NTHR, LDS_BYTES) != hipSuccess || per_cu < 1) fprintf(stderr, "kernel_launch: occupancy query says %d\n", per_cu);
        (void)hipGetLastError();
        grid = cus;
    }
    if (grid < 0) return;
    (void)hipMemsetAsync((char*)d_ws + WS_CTL, 0, CTL_ZERO_BYTES, stream);
    Args a{};
    a.x_prompt = (const float*)d_in[0]; a.x_sample = (const float*)d_in[1]; a.c_fk = (const float*)d_in[2]; a.c_fv = (const float*)d_in[3]; a.c_fl = (const float*)d_in[4];
    a.c_sk = (const float*)d_in[5]; a.c_sv = (const float*)d_in[6]; a.norm_g = (const float*)d_in[7]; a.w_in = (const float*)d_in[8]; a.b_f = (const float*)d_in[9];
    a.gn_a = (const float*)d_in[10]; a.gn_b = (const float*)d_in[11]; a.w_out = (const float*)d_in[12]; a.fin_g = (const float*)d_in[13];
    a.out = (float*)d_out; a.ws = (unsigned char*)d_ws;
#if MK_ONE_LAUNCH
    a.ph_lo = 0; a.ph_hi = N_PHASES;
    hipLaunchKernelGGL(fwd, dim3(grid), dim3(NTHR), LDS_BYTES, stream, a);
#else
    for (int p = 0; p < N_PHASES; ++p) { a.ph_lo = p; a.ph_hi = p + 1; hipLaunchKernelGGL(fwd, dim3(grid), dim3(NTHR), LDS_BYTES, stream, a); }
#endif
}
```
